# Optimizing an MI355X kernel written in HIP

```python
import math
import jax, jax.numpy as jnp
from jax import lax
import numpy as np

D_MODEL = 1024
BATCH = 2
SEQ = 8192
DEPTH = 4

N_MEM = 256
SSM_GROUP_CH = 16
SSM_STATE = 64
SSM_WIDTH = D_MODEL // 2
SSM_GROUPS = SSM_WIDTH // SSM_GROUP_CH
GMLP_WIDTH = D_MODEL // 2
GMLP_GROUPS = 8
GMLP_GROUP_CH = GMLP_WIDTH // GMLP_GROUPS
CHUNK = 128
MEM_HEADS = 4
MEM_WIDTH = D_MODEL // 2
MEM_HEAD_DIM = MEM_WIDTH // MEM_HEADS
N_BRANCH = 3
IN_WIDTH = SSM_WIDTH + 2 * GMLP_WIDTH + MEM_WIDTH
BRANCH_WIDTH = 512
N_GROUPS_MOE = 4
EXP_PER_GROUP = 8
N_EXPERTS = N_GROUPS_MOE * EXP_PER_GROUP
D_EXPERT = 256
TOP_K_INNER = 2
MOE_BLOCK = 128
DEEPNORM_ALPHA = (2.0 * DEPTH) ** 0.25
DEEPNORM_BETA = (8.0 * DEPTH) ** -0.25
LN_EPS = 1e-5

kernel_name = "hybrid_s5_gmlp_memattn_hmoe_deepnorm"


def _layer_norm(x, g, b):
    xf = x.astype(jnp.float32)
    mu = jnp.mean(xf, axis=-1, keepdims=True)
    var = jnp.mean(jnp.square(xf - mu), axis=-1, keepdims=True)
    y = (xf - mu) * lax.rsqrt(var + LN_EPS)
    return (y * g.astype(jnp.float32) + b.astype(jnp.float32)).astype(x.dtype)


def _diag_scan(lam_bar, bu, reverse):
    a = jnp.broadcast_to(lam_bar, bu.shape)

    def combine(left, right):
        a_l, b_l = left
        a_r, b_r = right
        return a_l * a_r, a_r * b_l + b_r

    _, h = lax.associative_scan(combine, (a, bu), axis=1, reverse=reverse)
    return h


def _s5_branch(u, lam_re, lam_im, log_step, b_re, b_im, c_re, c_im, d_skip, w_glu, b_glu):
    dtype = u.dtype
    bsz, seq, _ = u.shape
    f32 = jnp.float32
    uf = u.astype(f32).reshape(bsz, seq, SSM_GROUPS, SSM_GROUP_CH)
    uc = uf.astype(jnp.complex64)
    b_mat = lax.complex(b_re.astype(f32), b_im.astype(f32))
    c_mat = lax.complex(c_re.astype(f32), c_im.astype(f32))
    y = d_skip.astype(f32).reshape(SSM_GROUPS, SSM_GROUP_CH) * uf
    for direction in range(2):
        lam = lax.complex(lam_re[direction].astype(f32), lam_im[direction].astype(f32))
        step = jnp.exp(log_step[direction].astype(f32))[:, None]
        lam_bar = jnp.exp(lam * step)
        b_bar = ((lam_bar - 1.0) / lam)[:, :, None] * b_mat
        bu = jnp.einsum('gph,bsgh->bsgp', b_bar, uc)
        h = _diag_scan(lam_bar, bu, reverse=(direction == 1))
        y = y + jnp.einsum('ghp,bsgp->bsgh', c_mat, h).real
    y = jax.nn.gelu(y.reshape(bsz, seq, SSM_WIDTH))
    gate = jax.nn.sigmoid(y @ w_glu.astype(f32) + b_glu.astype(f32))
    return (y * gate).astype(dtype)


def _gmlp_branch(uv, ln_g, ln_b, w_s, b_s):
    uv = jax.nn.gelu(uv)
    u, v = jnp.split(uv, 2, axis=-1)
    v = _layer_norm(v, ln_g, ln_b)
    bsz, seq, _ = v.shape
    vc = v.reshape(bsz, seq // CHUNK, CHUNK, GMLP_GROUPS, GMLP_GROUP_CH)
    s = jnp.einsum('gij,bcjgd->bcigd', w_s, vc) + b_s.T[None, None, :, :, None]
    return u * s.reshape(bsz, seq, GMLP_WIDTH)


def _memory_attention(q, mem, w_kv):
    bsz, seq, _ = q.shape
    k, v = jnp.split(mem @ w_kv, 2, axis=-1)
    qh = q.reshape(bsz, seq, MEM_HEADS, MEM_HEAD_DIM)
    kh = k.reshape(bsz, N_MEM, MEM_HEADS, MEM_HEAD_DIM)
    vh = v.reshape(bsz, N_MEM, MEM_HEADS, MEM_HEAD_DIM)
    scores = jnp.einsum('bshd,bmhd->bhsm', qh, kh).astype(jnp.float32) * (MEM_HEAD_DIM ** -0.5)
    p = jax.nn.softmax(scores, axis=-1).astype(q.dtype)
    o = jnp.einsum('bhsm,bmhd->bshd', p, vh)
    return o.reshape(bsz, seq, MEM_WIDTH)


def _hier_moe(x, w_rg, b_rg, w_re, b_re, w_gate_e, w_up_e, w_down_e):
    bsz, seq, d = x.shape
    xt = x.reshape(-1, MOE_BLOCK, d)

    def block(xb):
        lg = (xb @ w_rg + b_rg).astype(jnp.float32)
        pg = jax.nn.softmax(lg, axis=-1)
        g_star = jnp.argmax(lg, axis=-1)
        g_oh = jax.nn.one_hot(g_star, N_GROUPS_MOE, dtype=jnp.float32)
        pg_sel = jnp.sum(pg * g_oh, axis=-1)
        le = (jnp.einsum('nd,gde->nge', xb, w_re) + b_re).astype(jnp.float32)
        le_sel = jnp.einsum('ng,nge->ne', g_oh, le)
        top_v, top_i = lax.top_k(le_sel, TOP_K_INNER)
        pe = jax.nn.softmax(top_v, axis=-1)
        expert_id = g_star[:, None] * EXP_PER_GROUP + top_i
        e_oh = jax.nn.one_hot(expert_id, N_EXPERTS, dtype=jnp.float32)
        weights = jnp.einsum('nk,nke->ne', pg_sel[:, None] * pe, e_oh).astype(xb.dtype)
        h = jax.nn.silu(jnp.einsum('nd,edf->nef', xb, w_gate_e)) * jnp.einsum('nd,edf->nef', xb, w_up_e)
        return jnp.einsum('nef,efd->nd', h * weights[:, :, None], w_down_e)

    return lax.map(block, xt).reshape(bsz, seq, d)


def setup_inputs(seed: int = 0) -> dict:
    key = jax.random.key(seed)
    ks = iter(jax.random.split(key, 40))
    L, D = DEPTH, D_MODEL
    f32 = jnp.float32

    def nrm(shape, scale):
        return jax.random.normal(next(ks), shape, f32) * scale

    n_idx = jnp.arange(SSM_STATE, dtype=f32)
    lam_re = -0.5 + nrm((L, 2, SSM_GROUPS, SSM_STATE), 0.01)
    lam_im = math.pi * n_idx + nrm((L, 2, SSM_GROUPS, SSM_STATE), 0.01)
    log_step = jax.random.uniform(next(ks), (L, 2, SSM_GROUPS), f32,
                                  minval=math.log(1e-3), maxval=math.log(1e-1))
    w_kv_k = nrm((L, D, MEM_WIDTH), D ** -0.5)
    w_kv_v = nrm((L, D, MEM_WIDTH), D ** -0.5 * DEEPNORM_BETA)
    return {
        "x": nrm((BATCH, SEQ, D), 1.0),
        "mem": nrm((BATCH, N_MEM, D), 1.0),
        "w_in": nrm((L, D, IN_WIDTH), D ** -0.5),
        "w_gate": nrm((L, D, N_BRANCH * D), D ** -0.5),
        "b_gate": nrm((L, N_BRANCH * D), 0.1),
        "ssm_lam_re": lam_re,
        "ssm_lam_im": lam_im,
        "ssm_log_step": log_step,
        "ssm_b_re": nrm((L, SSM_GROUPS, SSM_STATE, SSM_GROUP_CH), (2.0 * SSM_GROUP_CH) ** -0.5),
        "ssm_b_im": nrm((L, SSM_GROUPS, SSM_STATE, SSM_GROUP_CH), (2.0 * SSM_GROUP_CH) ** -0.5),
        "ssm_c_re": nrm((L, SSM_GROUPS, SSM_GROUP_CH, SSM_STATE), (2.0 * SSM_STATE) ** -0.5),
        "ssm_c_im": nrm((L, SSM_GROUPS, SSM_GROUP_CH, SSM_STATE), (2.0 * SSM_STATE) ** -0.5),
        "ssm_d": nrm((L, SSM_WIDTH), 1.0),
        "w_glu": nrm((L, SSM_WIDTH, SSM_WIDTH), SSM_WIDTH ** -0.5),
        "b_glu": nrm((L, SSM_WIDTH), 0.01),
        "gmlp_ln_g": 1.0 + nrm((L, GMLP_WIDTH), 0.01),
        "gmlp_ln_b": nrm((L, GMLP_WIDTH), 0.01),
        "w_spatial": nrm((L, GMLP_GROUPS, CHUNK, CHUNK), CHUNK ** -0.5),
        "b_spatial": 1.0 + nrm((L, GMLP_GROUPS, CHUNK), 0.01),
        "w_kv": jnp.concatenate([w_kv_k, w_kv_v], axis=-1),
        "w_br": nrm((L, N_BRANCH, BRANCH_WIDTH, D), BRANCH_WIDTH ** -0.5 * DEEPNORM_BETA),
        "w_out": nrm((L, D, D), D ** -0.5 * DEEPNORM_BETA),
        "ln1_g": 1.0 + nrm((L, D), 0.01),
        "ln1_b": nrm((L, D), 0.01),
        "w_router_g": nrm((L, D, N_GROUPS_MOE), D ** -0.5),
        "b_router_g": nrm((L, N_GROUPS_MOE), 0.01),
        "w_router_e": nrm((L, N_GROUPS_MOE, D, EXP_PER_GROUP), D ** -0.5),
        "b_router_e": nrm((L, N_GROUPS_MOE, EXP_PER_GROUP), 0.01),
        "w_exp_gate": nrm((L, N_EXPERTS, D, D_EXPERT), D ** -0.5),
        "w_exp_up": nrm((L, N_EXPERTS, D, D_EXPERT), D ** -0.5),
        "w_exp_down": nrm((L, N_EXPERTS, D_EXPERT, D), D_EXPERT ** -0.5 * DEEPNORM_BETA),
        "ln2_g": 1.0 + nrm((L, D), 0.01),
        "ln2_b": nrm((L, D), 0.01),
    }


def reference(x, mem, w_in, w_gate, b_gate, ssm_lam_re, ssm_lam_im, ssm_log_step,
              ssm_b_re, ssm_b_im, ssm_c_re, ssm_c_im, ssm_d, w_glu, b_glu,
              gmlp_ln_g, gmlp_ln_b, w_spatial, b_spatial, w_kv, w_br, w_out,
              ln1_g, ln1_b, w_router_g, b_router_g, w_router_e, b_router_e,
              w_exp_gate, w_exp_up, w_exp_down, ln2_g, ln2_b):
    bsz, seq, d = x.shape
    for l in range(DEPTH):
        proj = x @ w_in[l]
        u_ssm = proj[..., :SSM_WIDTH]
        uv_gmlp = proj[..., SSM_WIDTH:SSM_WIDTH + 2 * GMLP_WIDTH]
        q_mem = proj[..., SSM_WIDTH + 2 * GMLP_WIDTH:]
        y_ssm = _s5_branch(u_ssm, ssm_lam_re[l], ssm_lam_im[l], ssm_log_step[l],
                           ssm_b_re[l], ssm_b_im[l], ssm_c_re[l], ssm_c_im[l],
                           ssm_d[l], w_glu[l], b_glu[l])
        y_gmlp = _gmlp_branch(uv_gmlp, gmlp_ln_g[l], gmlp_ln_b[l], w_spatial[l], b_spatial[l])
        y_mem = _memory_attention(q_mem, mem, w_kv[l])
        gates = jax.nn.sigmoid(x @ w_gate[l] + b_gate[l]).reshape(bsz, seq, N_BRANCH, d)
        merged = (gates[:, :, 0] * (y_ssm @ w_br[l, 0])
                  + gates[:, :, 1] * (y_gmlp @ w_br[l, 1])
                  + gates[:, :, 2] * (y_mem @ w_br[l, 2]))
        x = _layer_norm(DEEPNORM_ALPHA * x + merged @ w_out[l], ln1_g[l], ln1_b[l])
        moe_out = _hier_moe(x, w_router_g[l], b_router_g[l], w_router_e[l], b_router_e[l],
                            w_exp_gate[l], w_exp_up[l], w_exp_down[l])
        x = _layer_norm(DEEPNORM_ALPHA * x + moe_out, ln2_g[l], ln2_b[l])
    return x
```

```cpp
#include <hip/hip_runtime.h>
#include <cstdio>
#include <cstdint>

#define LAS __attribute__((address_space(3)))
typedef unsigned short bf16;
typedef float f32x4 __attribute__((ext_vector_type(4)));
typedef float f32x2 __attribute__((ext_vector_type(2)));
typedef unsigned u32x4 __attribute__((ext_vector_type(4)));
typedef unsigned u32x2 __attribute__((ext_vector_type(2)));

constexpr int D = 1024, BATCH = 2, SEQ = 8192, M = BATCH * SEQ, DEPTH = 4;
constexpr int NMEM = 256, SSMW = 512, SG = 32, SGC = 16, SP = 64;
constexpr int GW = 512, GG = 8, GGC = 64, CHUNK = 128;
constexpr int MH = 4, MW = 512, MHD = 128;
constexpr int INW = 2048, NGATE = 3072;
constexpr int NGRP = 4, EPG = 8, NEXP = 32, DEXP = 256;
constexpr float ALPHA = 1.6817928305074290f;
constexpr float LN_EPS = 1e-5f;
constexpr int LCAP = 16640;
constexpr int SPCAP = 41216;

constexpr size_t MiB = 1u << 20;
constexpr size_t WS_CTL = 0, CTL_ZERO_BYTES = 1 * MiB;
constexpr size_t WS_X32 = 1 * MiB;
constexpr size_t WS_XB = 65 * MiB;
constexpr size_t WS_Z1 = 97 * MiB;
constexpr size_t WS_AEXT = 161 * MiB;
constexpr size_t WS_T0 = WS_AEXT;
constexpr size_t WS_X1B = WS_AEXT;
constexpr size_t WS_GU = 193 * MiB;
constexpr size_t WS_GV = 209 * MiB;
constexpr size_t WS_Q = 225 * MiB;
constexpr size_t WS_T1 = WS_GV;
constexpr size_t WS_GATES = 241 * MiB;
constexpr size_t WS_O2 = WS_GATES;
constexpr size_t WS_YS = 337 * MiB;
constexpr size_t WS_YSSM = 353 * MiB;
constexpr size_t WS_YGMLP = 369 * MiB;
constexpr size_t WS_YMEM = 385 * MiB;
constexpr size_t WS_MERGED = 401 * MiB;
constexpr size_t WS_SST = WS_MERGED;
constexpr size_t WS_KB = 433 * MiB;
constexpr size_t WS_VT = 435 * MiB;
constexpr size_t WS_HB = 437 * MiB;
constexpr size_t WS_LIST = 458 * MiB;
constexpr size_t WS_TOKW = 461 * MiB;
constexpr size_t WS_S5TAB = 461 * MiB + 512 * 1024;
constexpr size_t WS_WBE0 = 462 * MiB;
constexpr size_t WS_WBL = 478 * MiB;
constexpr size_t WS_WBE1 = 574 * MiB;
constexpr size_t WS_S5E = 526 * MiB;
constexpr size_t WS_S5BT = 542 * MiB;
constexpr size_t WS_END = 590 * MiB;
constexpr size_t WS_PTAB = WS_Z1;
constexpr size_t WS_KTAB = WS_Z1 + 4 * MiB;
constexpr size_t WS_YTMP = WS_Z1 + 16 * MiB;
constexpr int TCH = 16, NCHK = M / TCH;
constexpr int CW_DBG = 8;
constexpr int CW_CNT = 16384;
constexpr int CW_BAR = 4096;
constexpr int CW_TC = 65536;

__device__ __forceinline__ unsigned f2bf(float f) { unsigned u = __builtin_bit_cast(unsigned, f); return (u + 0x7fffu + ((u >> 16) & 1u)) >> 16; }
__device__ __forceinline__ float bf2f(unsigned short b) { return __builtin_bit_cast(float, (unsigned)b << 16); }
__device__ __forceinline__ float bflo(unsigned w) { return __builtin_bit_cast(float, w << 16); }
__device__ __forceinline__ float bfhi(unsigned w) { return __builtin_bit_cast(float, w & 0xffff0000u); }
__device__ __forceinline__ unsigned pk2(float lo, float hi) { return f2bf(lo) | (f2bf(hi) << 16); }
__device__ __forceinline__ float gelu_tanh(float x) { const float u = 0.7978845608028654f * (x + 0.044715f * x * x * x); return 0.5f * x * (1.f + tanhf(u)); }
__device__ __forceinline__ float sigmoidf_(float x) { return 1.f / (1.f + __expf(-x)); }
__device__ __forceinline__ float lane_xor(float v, int lane, int m) { return __builtin_bit_cast(float, __builtin_amdgcn_ds_bpermute((lane ^ m) << 2, __builtin_bit_cast(int, v))); }
__device__ __forceinline__ float wave_sum(float v, int lane) {
#pragma unroll
    for (int o = 1; o < 64; o <<= 1) v += lane_xor(v, lane, o);
    return v;
}
__device__ __forceinline__ float wave_max(float v, int lane) {
#pragma unroll
    for (int o = 1; o < 64; o <<= 1) v = fmaxf(v, lane_xor(v, lane, o));
    return v;
}

__device__ __forceinline__ void wave_sum4(float (&v)[4], int lane) {
    const bool b5 = (lane & 32) != 0, b4 = (lane & 16) != 0;
    float k0 = b5 ? v[2] : v[0], k1 = b5 ? v[3] : v[1]; const float s0 = b5 ? v[0] : v[2], s1 = b5 ? v[1] : v[3];
    k0 += lane_xor(s0, lane, 32); k1 += lane_xor(s1, lane, 32);
    float k = b4 ? k1 : k0; const float s = b4 ? k0 : k1;
    k += lane_xor(s, lane, 16);
    k += lane_xor(k, lane, 8); k += lane_xor(k, lane, 4); k += lane_xor(k, lane, 2); k += lane_xor(k, lane, 1);
    const int ki = __builtin_bit_cast(int, k);
    v[0] = __builtin_bit_cast(float, __builtin_amdgcn_readlane(ki, 0)); v[1] = __builtin_bit_cast(float, __builtin_amdgcn_readlane(ki, 16));
    v[2] = __builtin_bit_cast(float, __builtin_amdgcn_readlane(ki, 32)); v[3] = __builtin_bit_cast(float, __builtin_amdgcn_readlane(ki, 48));
}
__device__ __forceinline__ void wave_sum8(float (&v)[8], int lane) {
    const bool b5 = (lane & 32) != 0, b4 = (lane & 16) != 0, b3 = (lane & 8) != 0;
    float k[4], s[4];
#pragma unroll
    for (int i = 0; i < 4; ++i) { k[i] = b5 ? v[4 + i] : v[i]; s[i] = b5 ? v[i] : v[4 + i]; }
#pragma unroll
    for (int i = 0; i < 4; ++i) k[i] += lane_xor(s[i], lane, 32);
    float k2[2], s2[2];
#pragma unroll
    for (int i = 0; i < 2; ++i) { k2[i] = b4 ? k[2 + i] : k[i]; s2[i] = b4 ? k[i] : k[2 + i]; }
#pragma unroll
    for (int i = 0; i < 2; ++i) k2[i] += lane_xor(s2[i], lane, 16);
    float kk = b3 ? k2[1] : k2[0]; const float ss = b3 ? k2[0] : k2[1];
    kk += lane_xor(ss, lane, 8);
    kk += lane_xor(kk, lane, 4); kk += lane_xor(kk, lane, 2); kk += lane_xor(kk, lane, 1);
    const int ki = __builtin_bit_cast(int, kk);
    v[0] = __builtin_bit_cast(float, __builtin_amdgcn_readlane(ki, 0)); v[1] = __builtin_bit_cast(float, __builtin_amdgcn_readlane(ki, 8));
    v[2] = __builtin_bit_cast(float, __builtin_amdgcn_readlane(ki, 16)); v[3] = __builtin_bit_cast(float, __builtin_amdgcn_readlane(ki, 24));
    v[4] = __builtin_bit_cast(float, __builtin_amdgcn_readlane(ki, 32)); v[5] = __builtin_bit_cast(float, __builtin_amdgcn_readlane(ki, 40));
    v[6] = __builtin_bit_cast(float, __builtin_amdgcn_readlane(ki, 48)); v[7] = __builtin_bit_cast(float, __builtin_amdgcn_readlane(ki, 56));
}

#define XB_TMO      128
#define XB_XCNT(j)  (256  + 64 * (j))
#define XB_XSUB(j)  (1280 + 64 * (j))
#define XB_XGEN(j)  (2304 + 64 * (j))
#define XB_TOP      3328
#define XB_TOPGEN   3392
#define XCD_BAR_WORDS 3456
#define XB_SPIN_CAP (1u << 22)

__device__ __forceinline__ unsigned xb_ld(unsigned* p)              { return __hip_atomic_load(p, __ATOMIC_RELAXED, __HIP_MEMORY_SCOPE_AGENT); }
__device__ __forceinline__ unsigned xb_add(unsigned* p, unsigned v) { return __hip_atomic_fetch_add(p, v, __ATOMIC_RELAXED, __HIP_MEMORY_SCOPE_AGENT); }
__device__ __forceinline__ unsigned xb_xcc_id() { return (unsigned)__builtin_amdgcn_s_getreg((3 << 11) | 20) & 0xFu; }
#define XB_SPIN(cond, bar) do { unsigned _sp = 0; while (cond) { __builtin_amdgcn_s_sleep(1); \
    if ((++_sp & 255u) == 0u) { if (xb_ld(&(bar)[XB_TMO])) break; if (_sp > XB_SPIN_CAP) { atomicAdd(&(bar)[XB_TMO], 1u); break; } } } } while (0)

struct XcdBarrier { unsigned* bar; unsigned x; volatile LAS unsigned* st; };

__device__ __forceinline__ XcdBarrier xcd_barrier_post(unsigned* bar, volatile LAS unsigned* st) {
    XcdBarrier b; b.bar = bar; b.x = xb_xcc_id(); b.st = st;
    if (threadIdx.x == 0) (void)xb_add(&bar[XB_XCNT(b.x)], 1u);
    return b;
}
__device__ __forceinline__ void xcd_barrier_complete(unsigned* bar, unsigned x, unsigned& nloc, unsigned& nx) {
    const unsigned G = gridDim.x * gridDim.y * gridDim.z;
    unsigned sum, cnt, mine, sp = 0u;
    for (;;) {
        sum = 0u; cnt = 0u; mine = 0u;
#pragma unroll
        for (unsigned j = 0; j < 16; ++j) { const unsigned c = xb_ld(&bar[XB_XCNT(j)]); sum += c; cnt += (c > 0u) ? 1u : 0u; }
        mine = xb_ld(&bar[XB_XCNT(x)]);
        if (sum == G) break;
        __builtin_amdgcn_s_sleep(1);
        if ((++sp & 255u) == 0u) { if (xb_ld(&bar[XB_TMO])) break; if (sp > XB_SPIN_CAP) { atomicAdd(&bar[XB_TMO], 1u); break; } }
    }
    nloc = mine > 0u ? mine : 1u; nx = cnt > 0u ? cnt : 1u;
}
__device__ __forceinline__ void xcd_barrier(const XcdBarrier& b, const bool leader) {
    asm volatile("s_waitcnt vmcnt(0)" ::: "memory");
    __syncthreads();
    if (leader) {
        unsigned* bar = b.bar;
        unsigned bx = xb_xcc_id(); asm volatile("" : "+s"(bx));
        __builtin_amdgcn_s_waitcnt(0);
        unsigned nloc = b.st[0], nx = b.st[1];
        if (nloc == 0u) { xcd_barrier_complete(bar, bx, nloc, nx); b.st[0] = nloc; b.st[1] = nx; }
        const unsigned old = xb_add(&bar[XB_XSUB(bx)], 1u);
        const unsigned gen = old / nloc;
        if (old + 1u == (gen + 1u) * nloc) {
            __builtin_amdgcn_fence(__ATOMIC_RELEASE, "agent");
            asm volatile("s_waitcnt vmcnt(0)" ::: "memory");
            const unsigned og = xb_add(&bar[XB_TOP], 1u);
            const unsigned tg = og / nx;
            if (og + 1u == (tg + 1u) * nx) xb_add(&bar[XB_TOPGEN], 1u);
            else XB_SPIN(xb_ld(&bar[XB_TOPGEN]) == tg, bar);
            __builtin_amdgcn_fence(__ATOMIC_ACQUIRE, "agent");
            xb_add(&bar[XB_XGEN(bx)], 1u);
            asm volatile("s_waitcnt vmcnt(0)" ::: "memory");
        } else {
            XB_SPIN(xb_ld(&bar[XB_XGEN(bx)]) == gen, bar);
            __builtin_amdgcn_fence(__ATOMIC_ACQUIRE, "agent");
            asm volatile("s_waitcnt vmcnt(0)" ::: "memory");
        }
    }
    __syncthreads();
}

constexpr int LDS_BYTES = 151552;
constexpr int LDS_MISC = 147456;
constexpr int NT = 512;
constexpr int LDS_GOFF = 131072;

template <int NB, class AL, class BL, class EP>
__device__ __forceinline__ void ngemm_tile(float* sm, int K, const AL& aload, const BL& bload, const EP& epi) {
    const int tid = threadIdx.x;
    const int ar = tid >> 2, ak = (tid & 3) * 4;
    const int bk = tid >> 5, bc = (tid & 31) * 4;
    const int ty = tid >> 4, tx = tid & 15;
    float acc[NB][4][8];
#pragma unroll
    for (int nb = 0; nb < NB; ++nb)
#pragma unroll
        for (int i = 0; i < 4; ++i)
#pragma unroll
            for (int j = 0; j < 8; ++j) acc[nb][i][j] = 0.f;
    float* As = sm;
    float* Bs = sm + 16 * 132;
    for (int k0 = 0; k0 < K; k0 += 16) {
        float a4[4]; float b4[NB][4];
        aload(ar, k0 + ak, a4);
#pragma unroll
        for (int nb = 0; nb < NB; ++nb) bload(nb, k0 + bk, bc, b4[nb]);
        __syncthreads();
#pragma unroll
        for (int i = 0; i < 4; ++i) As[(ak + i) * 132 + ar] = a4[i];
#pragma unroll
        for (int nb = 0; nb < NB; ++nb) *(f32x4*)&Bs[(nb * 16 + bk) * 132 + bc] = (f32x4){b4[nb][0], b4[nb][1], b4[nb][2], b4[nb][3]};
        __syncthreads();
#pragma unroll 4
        for (int k = 0; k < 16; ++k) {
            const f32x4 av = *(const f32x4*)&As[k * 132 + ty * 4];
#pragma unroll
            for (int nb = 0; nb < NB; ++nb) {
                const f32x4 b0 = *(const f32x4*)&Bs[(nb * 16 + k) * 132 + tx * 8], b1 = *(const f32x4*)&Bs[(nb * 16 + k) * 132 + tx * 8 + 4];
#pragma unroll
                for (int i = 0; i < 4; ++i) {
#pragma unroll
                    for (int j = 0; j < 4; ++j) { acc[nb][i][j] += av[i] * b0[j]; acc[nb][i][4 + j] += av[i] * b1[j]; }
                }
            }
        }
    }
#pragma unroll
    for (int i = 0; i < 4; ++i)
#pragma unroll
        for (int j = 0; j < 8; ++j) epi(ty * 4 + i, tx * 8 + j, acc[0][i][j], acc[NB - 1][i][j]);
    __syncthreads();
}

struct ALbf16 {
    const bf16* A; int lda; int row0;
    __device__ __forceinline__ void operator()(int r, int k, float* o) const {
        const u32x2 w = *(const u32x2*)(A + (size_t)(row0 + r) * lda + k);
        o[0] = bflo(w.x); o[1] = bfhi(w.x); o[2] = bflo(w.y); o[3] = bfhi(w.y);
    }
};
struct ALf32 {
    const float* A; int lda; int row0;
    __device__ __forceinline__ void operator()(int r, int k, float* o) const {
        const f32x4 w = *(const f32x4*)(A + (size_t)(row0 + r) * lda + k);
        o[0] = w.x; o[1] = w.y; o[2] = w.z; o[3] = w.w;
    }
};
struct ALgather {
    const bf16* A; int lda; const int* list; int row0; int cnt;
    __device__ __forceinline__ void operator()(int r, int k, float* o) const {
        const int rr = row0 + r; const int tok = (rr < cnt) ? (list[rr] >> 1) : 0;
        const u32x2 w = *(const u32x2*)(A + (size_t)tok * lda + k);
        o[0] = bflo(w.x); o[1] = bfhi(w.x); o[2] = bflo(w.y); o[3] = bfhi(w.y);
    }
};
struct BLf32 {
    const float* B0; const float* B1; int ldb; int col0;
    __device__ __forceinline__ void operator()(int nb, int k, int c, float* o) const {
        const float* B = nb ? B1 : B0;
        const f32x4 w = *(const f32x4*)(B + (size_t)k * ldb + col0 + c);
        o[0] = w.x; o[1] = w.y; o[2] = w.z; o[3] = w.w;
    }
};


__device__ __forceinline__ int opaque_tid(const int wv) { int t = wv * 64 + (int)__builtin_amdgcn_mbcnt_hi(~0u, __builtin_amdgcn_mbcnt_lo(~0u, 0u)); asm volatile("" : "+v"(t)); return t; }
namespace pg8 {
typedef short bf16x8 __attribute__((ext_vector_type(8)));
constexpr int BM = 256, BK = 64, HALF = 128, HTB = HALF * BK * 2, STAGE_BYTES = 8 * HTB, NXCD = 8, WGM = 8;
__device__ __forceinline__ int lds_byte(int r, int c) { const int st = (r >> 4) * 2 + (c >> 5), rr = r & 15, cc = c & 31, ob = rr * 64 + cc * 2; return st * 1024 + (ob ^ (((ob >> 9) & 1) << 5)); }
__device__ __forceinline__ void stage_rc(int b, int& R, int& C) { const int st = b / 1024, sb = b % 1024, swz = sb ^ (((sb >> 9) & 1) << 5); R = (st >> 1) * 16 + swz / 64; C = (st & 1) * 32 + (swz % 64) / 2; }
__device__ __forceinline__ int perm32(int rho) { const int n = rho >> 4, i = rho & 15; return 8 * (i >> 2) + 4 * n + (i & 3); }

struct Unit { const char* A; const char* B; int pm, pn, x0, x1; };

template <class Epi, class Sched, bool GATHER = false, int NBH = 2>
__device__ __forceinline__ void gemm_phase(LAS unsigned char* lds, const int wv, const int lda, const int ldb, const int K, const Sched& S, Epi& E) {
    const int tid = opaque_tid(wv);
    const int wid = __builtin_amdgcn_readfirstlane(tid >> 6), lane = tid & 63, wr = wid >> 2, wc = wid & 3, fr = lane & 15, fq = lane >> 4;
    const int nt = K / BK;
    int sR[2], sC2[2]; unsigned voffB[2];
#pragma unroll
    for (int i = 0; i < 2; ++i) { int R, C; stage_rc(tid * 16 + i * 8192, R, C); const int Rb = Epi::PERM ? ((R & ~31) + perm32(R & 31)) : R;
        sR[i] = R; sC2[i] = C * 2; voffB[i] = (unsigned)(Rb * ldb + C) * 2u; }
    const size_t kstep = (size_t)(BK * 2);
    const unsigned hstepA = (unsigned)HALF * (unsigned)lda * 2u;
    const size_t hstepB = (size_t)HALF * ldb * 2;
    const unsigned ldsw = (unsigned)wid * 1024u;
    const int aoff = lds_byte(wr * 64 + fr, fq * 8), boff = lds_byte(wc * 32 + fr, fq * 8);
#define PG8_SA(b, h) (((b) * 2 + (h)) * HTB)
#define PG8_SB(b, h) ((4 + (b) * 2 + (h)) * HTB)
#define PG8_STAGE2(bufoff, gbase, v0, v1) do { \
        __builtin_amdgcn_global_load_lds((const unsigned*)((const char*)(gbase) + (v0)), (LAS unsigned*)(lds + (bufoff) + ldsw), 16, 0, 0); \
        __builtin_amdgcn_global_load_lds((const unsigned*)((const char*)(gbase) + (v1)), (LAS unsigned*)(lds + (bufoff) + ldsw + 8192), 16, 0, 0); } while (0)
#define PG8_STAGEB(bufoff, gbase) PG8_STAGE2(bufoff, gbase, voffB[0], voffB[1])
#define PG8_LDA(dst, b, h) do { _Pragma("unroll") for (int m = 0; m < 4; ++m) _Pragma("unroll") for (int k = 0; k < 2; ++k) dst[m][k] = *(const LAS bf16x8*)(lds + PG8_SA(b, h) + aoff + m * 2048 + k * 1024); } while (0)
#define PG8_LDB(dst, b, h) do { _Pragma("unroll") for (int n = 0; n < 2; ++n) _Pragma("unroll") for (int k = 0; k < 2; ++k) dst[n][k] = *(const LAS bf16x8*)(lds + PG8_SB(b, h) + boff + n * 2048 + k * 1024); } while (0)
#define PG8_MMA(ai, bj, At, Bt) do { __builtin_amdgcn_s_setprio(1); _Pragma("unroll") for (int m = 0; m < 4; ++m) _Pragma("unroll") for (int n = 0; n < 2; ++n) _Pragma("unroll") for (int k = 0; k < 2; ++k) \
        acc[ai][bj][m][n] = __builtin_amdgcn_mfma_f32_16x16x32_bf16(Bt[n][k], At[m][k], acc[ai][bj][m][n], 0, 0, 0); __builtin_amdgcn_s_setprio(0); } while (0)
#define PG8_WAIT_V(n) asm volatile("s_waitcnt vmcnt(" #n ")" ::: "memory")
#define PG8_WAIT_L(n) asm volatile("s_waitcnt lgkmcnt(" #n ")" ::: "memory")
#define PG8_BAR __builtin_amdgcn_s_barrier()
#define PG8_SCHED __builtin_amdgcn_sched_barrier(0)
    Unit cur, nxt; int ui = 0;
    if (!S.next(0, cur)) return;
    f32x4 acc[2][NBH][4][2];
#pragma unroll
    for (int a = 0; a < 2; ++a)
#pragma unroll
        for (int b = 0; b < NBH; ++b)
#pragma unroll
            for (int m = 0; m < 4; ++m)
#pragma unroll
                for (int n = 0; n < 2; ++n) acc[a][b][m][n] = (f32x4){0.f, 0.f, 0.f, 0.f};
    bf16x8 At[4][2], B0[2][2], B1[2][2];
    unsigned voffA[2]; unsigned ga[2][2];
#pragma unroll
    for (int i = 0; i < 2; ++i) voffA[i] = (unsigned)(sR[i] * lda) * 2u + (unsigned)sC2[i];
    if constexpr (GATHER) {
#pragma unroll
        for (int i = 0; i < 2; ++i) { ga[0][i] = S.row_off(cur, sR[i]) + (unsigned)sC2[i]; ga[1][i] = S.row_off(cur, HALF + sR[i]) + (unsigned)sC2[i]; }
    }
#define PG8_STAGEA(bufoff, gbase, h, nx) do { if constexpr (GATHER) { PG8_STAGE2(bufoff, gbase, ga[h][0], ga[h][1]); } \
        else { PG8_STAGE2(bufoff, (gbase) + (h) * (size_t)hstepA, voffA[0], voffA[1]); } } while (0)
    const char* cA = cur.A; const char* cB = cur.B;
    if constexpr (Epi::HAS_PRE) { const int t3 = opaque_tid(wv) & 63; E.pre(cur, wr, wc, t3 & 15, t3 >> 4); }
    if constexpr (NBH == 2) {
        PG8_STAGEB(PG8_SB(0, 0), cB); PG8_STAGEB(PG8_SB(0, 1), cB + hstepB); PG8_STAGEA(PG8_SA(0, 0), cA, 0, false); PG8_STAGEA(PG8_SA(0, 1), cA, 1, false);
        if (wr == 1) PG8_BAR;
        PG8_WAIT_V(2); PG8_BAR;
        PG8_STAGEB(PG8_SB(1, 0), cB + kstep); PG8_STAGEA(PG8_SA(1, 0), cA + kstep, 0, false); PG8_STAGEB(PG8_SB(1, 1), cB + hstepB + kstep);
        PG8_WAIT_V(6); PG8_BAR;
    } else {
        PG8_STAGEB(PG8_SB(0, 0), cB); PG8_STAGEA(PG8_SA(0, 0), cA, 0, false); PG8_STAGEA(PG8_SA(0, 1), cA, 1, false);
        if (wr == 1) PG8_BAR;
        PG8_WAIT_V(2); PG8_BAR;
        PG8_STAGEB(PG8_SB(1, 0), cB + kstep); PG8_STAGEA(PG8_SA(1, 0), cA + kstep, 0, false);
        PG8_WAIT_V(4); PG8_BAR;
    }
#pragma unroll 1
    for (;;) {
        const bool has_next = S.next(ui + 1, nxt);
        const char* nA = has_next ? nxt.A : cA; const char* nB = has_next ? nxt.B : cB;
#pragma unroll 1
        for (int t = 0; t < nt; t += 2) {
            const bool last = (t == nt - 2);
            const char* a1 = cA + (size_t)(t + 1) * kstep;
            const char* a2 = last ? nA : cA + (size_t)(t + 2) * kstep; const char* b2 = last ? nB : cB + (size_t)(t + 2) * kstep;
            const char* a3 = a2 + kstep; const char* b3 = b2 + kstep;
            if constexpr (NBH == 2) {
            PG8_LDB(B0, 0, 0); PG8_LDB(B1, 0, 1); PG8_SCHED; PG8_LDA(At, 0, 0); PG8_STAGEA(PG8_SA(1, 1), a1, 1, false);
            PG8_WAIT_V(8); PG8_WAIT_L(0); PG8_BAR; PG8_MMA(0, 0, At, B0); PG8_MMA(0, 1, At, B1); PG8_BAR; PG8_SCHED;
            PG8_LDA(At, 0, 1); PG8_STAGEB(PG8_SB(0, 0), b2); PG8_STAGEB(PG8_SB(0, 1), b2 + hstepB); PG8_STAGEA(PG8_SA(0, 0), a2, 0, last);
            PG8_WAIT_V(8); PG8_WAIT_L(0); PG8_BAR; PG8_MMA(1, 0, At, B0); PG8_MMA(1, 1, At, B1); PG8_BAR; PG8_SCHED;
            PG8_LDB(B0, 1, 0); PG8_LDB(B1, 1, 1); PG8_SCHED; PG8_LDA(At, 1, 0); PG8_STAGEA(PG8_SA(0, 1), a2, 1, last);
            PG8_WAIT_V(8); PG8_WAIT_L(0); PG8_BAR; PG8_MMA(0, 0, At, B0); PG8_MMA(0, 1, At, B1); PG8_BAR; PG8_SCHED;
            PG8_LDA(At, 1, 1); PG8_STAGEB(PG8_SB(1, 0), b3); PG8_STAGEB(PG8_SB(1, 1), b3 + hstepB); PG8_STAGEA(PG8_SA(1, 0), a3, 0, last);
            PG8_WAIT_V(8); PG8_WAIT_L(0); PG8_BAR; PG8_MMA(1, 0, At, B0); PG8_MMA(1, 1, At, B1); PG8_BAR; PG8_SCHED;
            } else {
            PG8_LDB(B0, 0, 0); PG8_SCHED; PG8_LDA(At, 0, 0); PG8_STAGEA(PG8_SA(1, 1), a1, 1, false);
            PG8_WAIT_V(6); PG8_WAIT_L(0); PG8_BAR; PG8_MMA(0, 0, At, B0); PG8_BAR; PG8_SCHED;
            PG8_LDA(At, 0, 1); PG8_STAGEB(PG8_SB(0, 0), b2); PG8_STAGEA(PG8_SA(0, 0), a2, 0, last);
            PG8_WAIT_V(6); PG8_WAIT_L(0); PG8_BAR; PG8_MMA(1, 0, At, B0); PG8_BAR; PG8_SCHED;
            PG8_LDB(B0, 1, 0); PG8_SCHED; PG8_LDA(At, 1, 0); PG8_STAGEA(PG8_SA(0, 1), a2, 1, last);
            PG8_WAIT_V(6); PG8_WAIT_L(0); PG8_BAR; PG8_MMA(0, 0, At, B0); PG8_BAR; PG8_SCHED;
            PG8_LDA(At, 1, 1); PG8_STAGEB(PG8_SB(1, 0), b3); PG8_STAGEA(PG8_SA(1, 0), a3, 0, last);
            PG8_WAIT_V(6); PG8_WAIT_L(0); PG8_BAR; PG8_MMA(1, 0, At, B0); PG8_BAR; PG8_SCHED;
            }
        }
        if (wr == 0) PG8_BAR;
        { const int t3 = opaque_tid(wv) & 63; E(acc, cur, wr, wc, t3 & 15, t3 >> 4); }
        if (!has_next) break;
#pragma unroll
        for (int a = 0; a < 2; ++a)
#pragma unroll
            for (int b = 0; b < NBH; ++b)
#pragma unroll
                for (int m = 0; m < 4; ++m)
#pragma unroll
                    for (int n = 0; n < 2; ++n) acc[a][b][m][n] = (f32x4){0.f, 0.f, 0.f, 0.f};
        cur = nxt; cA = nA; cB = nB; ++ui;
        if constexpr (Epi::HAS_PRE) { const int t3 = opaque_tid(wv) & 63; E.pre(cur, wr, wc, t3 & 15, t3 >> 4); }
        if (wr == 1) PG8_BAR;
    }
    PG8_WAIT_V(0);
    PG8_BAR;
#undef PG8_SA
#undef PG8_SB
#undef PG8_STAGE2
#undef PG8_STAGEB
#undef PG8_STAGEA
#undef PG8_LDA
#undef PG8_LDB
#undef PG8_MMA
#undef PG8_WAIT_V
#undef PG8_WAIT_L
#undef PG8_BAR
#undef PG8_SCHED
}

struct DenseOrder {
    const char* A; const char* B; size_t tstepA, tstepB; int nM, nN, nwg, G, c;
    __device__ __forceinline__ void init(const void* A_, const void* B_, int Mr, int N, int lda, int ldb, int G_, int c_) {
        A = (const char*)A_; B = (const char*)B_; tstepA = (size_t)BM * lda * 2; tstepB = (size_t)BM * ldb * 2; nM = Mr / BM; nN = N / BM; nwg = nM * nN; G = G_; c = c_; }
    __device__ __forceinline__ bool next(int i, Unit& u) const {
        const long L = (long)i * G + c; if (L >= nwg) return false;
        int wgid = (int)L; { const int q = nwg / NXCD, r = nwg % NXCD, xcd = wgid % NXCD, off = wgid / NXCD; wgid = (xcd < r ? xcd * (q + 1) : r * (q + 1) + (xcd - r) * q) + off; }
        const int nig = WGM * nN, gid = wgid / nig, fm = gid * WGM, gsz = (nM - fm) < WGM ? (nM - fm) : WGM;
        u.pm = fm + ((wgid % nig) % gsz); u.pn = (wgid % nig) / gsz; u.x0 = 0; u.x1 = 0;
        u.A = A + (size_t)u.pm * tstepA; u.B = B + (size_t)u.pn * tstepB; return true;
    }
};
}

__device__ __forceinline__ float gelu_fast(float x) { const float u2 = -2.3022081984f * (x + 0.044715f * x * x * x); return x * __builtin_amdgcn_rcpf(1.f + __builtin_amdgcn_exp2f(u2)); }
__device__ __forceinline__ float sigm_fast(float x) { return __builtin_amdgcn_rcpf(1.f + __builtin_amdgcn_exp2f(-1.4426950408889634f * x)); }
__device__ __forceinline__ u32x4 pack8(const f32x4 a, const f32x4 b) { u32x4 w; w.x = pk2(a.x, a.y); w.y = pk2(a.z, a.w); w.z = pk2(b.x, b.y); w.w = pk2(b.z, b.w); return w; }
__device__ __forceinline__ void unpack8(const u32x4 w, f32x4& a, f32x4& b) { a = (f32x4){bflo(w.x), bfhi(w.x), bflo(w.y), bfhi(w.y)}; b = (f32x4){bflo(w.z), bfhi(w.z), bflo(w.w), bfhi(w.w)}; }

typedef const f32x4 (&AccRef)[2][2][4][2];
typedef const f32x4 (&AccRef1)[2][1][4][2];
struct EpiP1 {
    static constexpr bool PERM = true;
    static constexpr bool HAS_PRE = false;
    bf16 *UG, *GU, *GV, *QB, *GATES; const float* b_gate;
    __device__ __forceinline__ void operator()(AccRef acc, const pg8::Unit& u, int wr, int wc, int fr, int fq) const {
        asm volatile("" : "+v"(fr), "+v"(fq));
        const int pn = u.pn;
        f32x4 gb0[2], gb1[2];
#pragma unroll
        for (int bj = 0; bj < 2; ++bj) { const int c = ((pn >= 8) ? (pn - 8) * 256 : 0) + bj * 128 + wc * 32 + 8 * fq; gb0[bj] = *(const f32x4*)(b_gate + c); gb1[bj] = *(const f32x4*)(b_gate + c + 4); }
#pragma unroll
        for (int ai = 0; ai < 2; ++ai)
#pragma unroll
            for (int m = 0; m < 4; ++m) {
                const size_t row = (size_t)u.pm * 256 + ai * 128 + wr * 64 + m * 16 + fr;
#pragma unroll
                for (int bj = 0; bj < 2; ++bj) {
                    const int cl = bj * 128 + wc * 32 + 8 * fq;
                    f32x4 v0 = acc[ai][bj][m][0], v1 = acc[ai][bj][m][1];
                    if (pn < 2) { const int c = pn * 256 + cl; *(u32x4*)(UG + ((size_t)(c >> 4) * NCHK + (row >> 4)) * 512 + (row & 15) * 16 + (c & 15)) = pack8(v0, v1); }
                    else if (pn < 6) {
#pragma unroll
                        for (int j = 0; j < 4; ++j) { v0[j] = gelu_fast(v0[j]); v1[j] = gelu_fast(v1[j]); }
                        bf16* dst = (pn < 4) ? (GU + row * 512 + (pn - 2) * 256 + cl) : (GV + row * 512 + (pn - 4) * 256 + cl);
                        *(u32x4*)dst = pack8(v0, v1);
                    }
                    else if (pn < 8) { *(u32x4*)(QB + row * 512 + (pn - 6) * 256 + cl) = pack8(v0, v1); }
                    else {
                        const int c = (pn - 8) * 256 + cl;
#pragma unroll
                        for (int j = 0; j < 4; ++j) { v0[j] = sigm_fast(v0[j] + gb0[bj][j]); v1[j] = sigm_fast(v1[j] + gb1[bj][j]); }
                        *(u32x4*)(GATES + row * NGATE + c) = pack8(v0, v1);
                    }
                }
            }
    }
};
struct EpiKV {
    static constexpr bool PERM = true;
    static constexpr bool HAS_PRE = false;
    bf16 *KBl, *VTl;
    __device__ __forceinline__ void operator()(AccRef acc, const pg8::Unit& u, int wr, int wc, int fr, int fq) const {
        asm volatile("" : "+v"(fr), "+v"(fq));
#pragma unroll
        for (int ai = 0; ai < 2; ++ai)
#pragma unroll
            for (int m = 0; m < 4; ++m) {
                const int row = u.pm * 256 + ai * 128 + wr * 64 + m * 16 + fr, b = u.x0 * 2 + (row >> 8), mm = row & 255;
#pragma unroll
                for (int bj = 0; bj < 2; ++bj) {
                    const int c = u.pn * 256 + bj * 128 + wc * 32 + 8 * fq;
                    const f32x4 v0 = acc[ai][bj][m][0], v1 = acc[ai][bj][m][1];
                    if (c < 512) { const int h = c >> 7, d = c & 127; *(u32x4*)(KBl + (((size_t)b * 4 + h) * 256 + mm) * 128 + d) = pack8(v0, v1); }
                    else { const int cc = c - 512, h = cc >> 7, d = cc & 127; bf16* p = VTl + (((size_t)b * 4 + h) * 128 + d) * 256 + mm;
#pragma unroll
                        for (int j = 0; j < 4; ++j) { p[(size_t)j * 256] = (bf16)f2bf(v0[j]); p[(size_t)(4 + j) * 256] = (bf16)f2bf(v1[j]); } }
                }
            }
    }
};
struct EpiGLU {
    static constexpr bool PERM = true;
    static constexpr bool HAS_PRE = false;
    const bf16* YS; bf16* YSSM; const float* b_glu;
    __device__ __forceinline__ void operator()(AccRef1 acc, const pg8::Unit& u, int wr, int wc, int fr, int fq) const {
        asm volatile("" : "+v"(fr), "+v"(fq));
        const int c0 = u.pn * 128 + wc * 32 + 8 * fq;
        const f32x4 b0 = *(const f32x4*)(b_glu + c0), b1 = *(const f32x4*)(b_glu + c0 + 4);
        u32x4 yv[2][4];
#pragma unroll
        for (int ai = 0; ai < 2; ++ai)
#pragma unroll
            for (int m = 0; m < 4; ++m) yv[ai][m] = *(const u32x4*)(YS + ((size_t)u.pm * 256 + ai * 128 + wr * 64 + m * 16 + fr) * 512 + c0);
        __builtin_amdgcn_sched_barrier(0);
#pragma unroll
        for (int ai = 0; ai < 2; ++ai)
#pragma unroll
            for (int m = 0; m < 4; ++m) {
                f32x4 v0 = acc[ai][0][m][0], v1 = acc[ai][0][m][1], y0, y1; unpack8(yv[ai][m], y0, y1);
#pragma unroll
                for (int j = 0; j < 4; ++j) { v0[j] = y0[j] * sigm_fast(v0[j] + b0[j]); v1[j] = y1[j] * sigm_fast(v1[j] + b1[j]); }
                *(u32x4*)(YSSM + ((size_t)u.pm * 256 + ai * 128 + wr * 64 + m * 16 + fr) * 512 + c0) = pack8(v0, v1);
            }
    }
};
struct GluOrder {
    const char* A; const char* B; int G, c;
    __device__ __forceinline__ bool next(int i, pg8::Unit& u) const {
        const int t = i * G + c; if (t >= 256) return false;
        const int x = t & 7, k = t >> 3; u.pm = x * 8 + (k >> 2); u.pn = k & 3; u.x0 = 0; u.x1 = 0;
        u.A = A + (size_t)u.pm * 256 * 512 * 2; u.B = B + (size_t)u.pn * 128 * 512 * 2; return true;
    }
};
template <int MODE> struct EpiMerge {
    static constexpr bool PERM = true;
    static constexpr bool HAS_PRE = false;
    const bf16* GATESb;
    bf16* dst; const bf16* p0; const bf16* p1;
    __device__ __forceinline__ void operator()(AccRef acc, const pg8::Unit& u, int wr, int wc, int fr, int fq) const {
        asm volatile("" : "+v"(fr), "+v"(fq));
        const int c0 = u.pn * 256 + wc * 32 + 8 * fq;
#pragma unroll
        for (int ai = 0; ai < 2; ++ai)
#pragma unroll
            for (int mh = 0; mh < 2; ++mh) {
                u32x4 gv[2][2], av[2][2], cv[2][2];
#pragma unroll
                for (int mm = 0; mm < 2; ++mm)
#pragma unroll
                    for (int bj = 0; bj < 2; ++bj) {
                        const size_t row = (size_t)u.pm * 256 + ai * 128 + wr * 64 + (mh * 2 + mm) * 16 + fr;
                        gv[mm][bj] = *(const u32x4*)(GATESb + row * NGATE + c0 + bj * 128);
                        if (MODE == 1) { av[mm][bj] = *(const u32x4*)(p0 + row * D + c0 + bj * 128); cv[mm][bj] = *(const u32x4*)(p1 + row * D + c0 + bj * 128); }
                    }
                __builtin_amdgcn_sched_barrier(0);
#pragma unroll
                for (int mm = 0; mm < 2; ++mm)
#pragma unroll
                    for (int bj = 0; bj < 2; ++bj) {
                        const int m = mh * 2 + mm; const size_t row = (size_t)u.pm * 256 + ai * 128 + wr * 64 + m * 16 + fr;
                        f32x4 v0 = acc[ai][bj][m][0], v1 = acc[ai][bj][m][1], g0, g1; unpack8(gv[mm][bj], g0, g1);
                        v0 = v0 * g0; v1 = v1 * g1;
                        if (MODE == 1) { f32x4 a0, a1, c0v, c1v; unpack8(av[mm][bj], a0, a1); unpack8(cv[mm][bj], c0v, c1v); v0 = v0 + a0 + c0v; v1 = v1 + a1 + c1v; }
                        *(u32x4*)(dst + row * D + c0 + bj * 128) = pack8(v0, v1);
                    }
            }
    }
};
struct MergeOrder {
    const char* Y0; const char* Y1; const char* Y2; const char* W; int G, c;
    __device__ __forceinline__ bool next(int i, pg8::Unit& u) const {
        const int ts = i / 3, bi = i - ts * 3, t = ts * G + c; if (t >= 512) return false;
        const int x = t & 7, k = t >> 3; u.pm = x * 8 + (k >> 3); u.pn = k & 7; u.x1 = bi; u.x0 = (bi == 2) ? 0 : bi + 1;
        u.A = ((u.x0 == 0) ? Y0 : (u.x0 == 1) ? Y1 : Y2) + (size_t)u.pm * 256 * 512 * 2; u.B = W + ((size_t)u.x0 * 1024 + (size_t)u.pn * 128) * 512 * 2; return true;
    }
};
struct EpiMergeF {
    static constexpr bool PERM = true;
    static constexpr bool HAS_PRE = true;
    const bf16* GATES; bf16* MERGED;
    f32x4 tot[2][4][2];
    u32x4 gv[2][4];
    __device__ __forceinline__ void pre(const pg8::Unit& u, int wr, int wc, int fr, int fq) {
        const int c = u.pn * 128 + wc * 32 + 8 * fq;
#pragma unroll
        for (int ai = 0; ai < 2; ++ai)
#pragma unroll
            for (int m = 0; m < 4; ++m) gv[ai][m] = *(const u32x4*)(GATES + ((size_t)u.pm * 256 + ai * 128 + wr * 64 + m * 16 + fr) * NGATE + u.x0 * D + c);
    }
    __device__ __forceinline__ void operator()(AccRef1 acc, const pg8::Unit& u, int wr, int wc, int fr, int fq) {
        asm volatile("" : "+v"(fr), "+v"(fq));
        const int c = u.pn * 128 + wc * 32 + 8 * fq, bi = u.x1;
#pragma unroll
        for (int ai = 0; ai < 2; ++ai)
#pragma unroll
            for (int m = 0; m < 4; ++m) {
                f32x4 g0, g1; unpack8(gv[ai][m], g0, g1);
                f32x4 v0 = acc[ai][0][m][0] * g0, v1 = acc[ai][0][m][1] * g1;
                if (bi != 0) { v0 = v0 + tot[ai][m][0]; v1 = v1 + tot[ai][m][1]; }
                if (bi == 2) *(u32x4*)(MERGED + ((size_t)u.pm * 256 + ai * 128 + wr * 64 + m * 16 + fr) * D + c) = pack8(v0, v1);
                else { tot[ai][m][0] = v0; tot[ai][m][1] = v1; }
            }
    }
};
struct EpiOut {
    static constexpr bool PERM = false;
    static constexpr bool HAS_PRE = false;
    const bf16* XB; bf16* Z1;
    __device__ __forceinline__ void operator()(AccRef acc, const pg8::Unit& u, int wr, int wc, int fr, int fq) const {
        asm volatile("" : "+v"(fr), "+v"(fq));
        const int c0 = u.pn * 256 + wc * 32 + 4 * fq;
#pragma unroll
        for (int ai = 0; ai < 2; ++ai)
#pragma unroll
            for (int mh = 0; mh < 2; ++mh) {
                u32x2 xv[2][2][2];
#pragma unroll
                for (int mm = 0; mm < 2; ++mm)
#pragma unroll
                    for (int bj = 0; bj < 2; ++bj)
#pragma unroll
                        for (int n = 0; n < 2; ++n) xv[mm][bj][n] = *(const u32x2*)(XB + ((size_t)u.pm * 256 + ai * 128 + wr * 64 + (mh * 2 + mm) * 16 + fr) * D + c0 + bj * 128 + 16 * n);
                __builtin_amdgcn_sched_barrier(0);
#pragma unroll
                for (int mm = 0; mm < 2; ++mm)
#pragma unroll
                    for (int bj = 0; bj < 2; ++bj)
#pragma unroll
                        for (int n = 0; n < 2; ++n) { const int m = mh * 2 + mm;
                            const f32x4 z = (f32x4){bflo(xv[mm][bj][n].x), bfhi(xv[mm][bj][n].x), bflo(xv[mm][bj][n].y), bfhi(xv[mm][bj][n].y)} * ALPHA + acc[ai][bj][m][n];
                            u32x2 zw; zw.x = pk2(z.x, z.y); zw.y = pk2(z.z, z.w);
                            *(u32x2*)(Z1 + ((size_t)u.pm * 256 + ai * 128 + wr * 64 + m * 16 + fr) * D + c0 + bj * 128 + 16 * n) = zw; }
            }
    }
};
struct S5Order { const char* A; const char* B; size_t bstep; int G, c;
    __device__ __forceinline__ bool next(int i, pg8::Unit& u) const { const int L = i * G + c; if (L >= 128) return false;
        u.x0 = (L & 7) * 4 + (L >> 5); u.pm = (L >> 3) & 3; u.pn = 0; u.x1 = 0;        u.A = A + ((size_t)u.x0 * NCHK + (size_t)u.pm * 256) * 1024; u.B = B + (size_t)u.x0 * bstep; return true; } };
struct EpiS5St {
    static constexpr bool PERM = false;
    static constexpr bool HAS_PRE = false;
    float* SST;
    __device__ __forceinline__ void operator()(AccRef acc, const pg8::Unit& u, int wr, int wc, int fr, int fq) const {
        asm volatile("" : "+v"(fr), "+v"(fq));
#pragma unroll
        for (int ai = 0; ai < 2; ++ai)
#pragma unroll
            for (int m = 0; m < 4; ++m) {
                const size_t chunk = (size_t)u.pm * 256 + ai * 128 + wr * 64 + m * 16 + fr;
                float* rowp = SST + ((size_t)u.x0 * NCHK + chunk) * 256;
#pragma unroll
                for (int bj = 0; bj < 2; ++bj)
#pragma unroll
                    for (int n = 0; n < 2; ++n) *(f32x4*)(rowp + bj * 128 + wc * 32 + 16 * n + 4 * fq) = acc[ai][bj][m][n];
            }
    }
};
struct EpiS5Out {
    static constexpr bool PERM = true;
    static constexpr bool HAS_PRE = false;
    bf16* YS;
    __device__ __forceinline__ void operator()(AccRef acc, const pg8::Unit& u, int wr, int wc, int fr, int fq) const {
        asm volatile("" : "+v"(fr), "+v"(fq));
#pragma unroll
        for (int ai = 0; ai < 2; ++ai)
#pragma unroll
            for (int m = 0; m < 4; ++m) {
                const size_t chunk = (size_t)u.pm * 256 + ai * 128 + wr * 64 + m * 16 + fr;
#pragma unroll
                for (int bj = 0; bj < 2; ++bj) {
                    const int n0 = bj * 128 + wc * 32 + 8 * fq, s = n0 >> 4, h0 = n0 & 15;
                    f32x4 v0 = acc[ai][bj][m][0], v1 = acc[ai][bj][m][1];
#pragma unroll
                    for (int j = 0; j < 4; ++j) { v0[j] = gelu_fast(v0[j]); v1[j] = gelu_fast(v1[j]); }
                    *(u32x4*)(YS + (chunk * 16 + s) * 512 + u.x0 * 16 + h0) = pack8(v0, v1);
                }
            }
    }
};
struct MoeTab { int tb[33]; int sb[33]; int cn[32]; };
__device__ __forceinline__ int moe_ntile_x(const LAS MoeTab* T, int x, int NX) {
    int n = 0;
#pragma unroll 1
    for (int e = x; e < NEXP; e += NX) n += __builtin_amdgcn_readfirstlane(T->tb[e + 1]) - __builtin_amdgcn_readfirstlane(T->tb[e]);
    return n;
}
__device__ __forceinline__ void moe_local_tile(const LAS MoeTab* T, int x, int NX, int lt, int& e_out, int& pm_out) {
    int e = x;
#pragma unroll 1
    for (; e + NX < NEXP; e += NX) { const int n = __builtin_amdgcn_readfirstlane(T->tb[e + 1]) - __builtin_amdgcn_readfirstlane(T->tb[e]); if (lt < n) break; lt -= n; }
    e_out = e; pm_out = lt;
}
struct MoeOrderGU {
    const char* X1Bp; const char* WGU; const int* LIST; int e, pm, cnt, pn;
    __device__ __forceinline__ bool next(int i, pg8::Unit& u) const {
        if (i >= 1) return false;
        u.pm = pm; u.pn = pn; u.x0 = e; u.x1 = cnt;
        u.A = X1Bp; u.B = WGU + ((size_t)e * 512 + (size_t)pn * 256) * (D * 2); return true;
    }
    __device__ __forceinline__ unsigned row_off(const pg8::Unit& u, int r) const {
        const int rr = u.pm * 256 + r; const int tok = (rr < u.x1) ? (LIST[(size_t)u.x0 * LCAP + rr] >> 1) : 0;
        return (unsigned)tok * (unsigned)(D * 2);
    }
};
struct EpiMoeGU {
    static constexpr bool PERM = true;
    static constexpr bool HAS_PRE = false;
    const LAS MoeTab* T; const int* LIST; const float* TOKW; bf16* HB;
    float w[2][4];
    __device__ __forceinline__ void init(int e, int pm, int cnt, int tid) {
        const int wr = tid >> 8, fr = tid & 15; int pr[2][4];
#pragma unroll
        for (int ai = 0; ai < 2; ++ai)
#pragma unroll
            for (int m = 0; m < 4; ++m) { const int rr = pm * 256 + ai * 128 + wr * 64 + m * 16 + fr; pr[ai][m] = (rr < cnt) ? LIST[(size_t)e * LCAP + rr] : 0; }
#pragma unroll
        for (int ai = 0; ai < 2; ++ai)
#pragma unroll
            for (int m = 0; m < 4; ++m) w[ai][m] = TOKW[pr[ai][m]];
    }
    __device__ __forceinline__ void operator()(AccRef acc, const pg8::Unit& u, int wr, int wc, int fr, int fq) {
        asm volatile("" : "+v"(fr), "+v"(fq));
        const int e = u.x0, cnt = u.x1, sb = __builtin_amdgcn_readfirstlane(T->sb[e]);
#pragma unroll
        for (int ai = 0; ai < 2; ++ai)
#pragma unroll
            for (int m = 0; m < 4; ++m) {
                const int rr = u.pm * 256 + ai * 128 + wr * 64 + m * 16 + fr;
                if (rr < cnt) {
                    const int f = u.pn * 128 + wc * 32 + 8 * fq;
                    f32x4 g0 = acc[ai][0][m][0], g1 = acc[ai][0][m][1]; const f32x4 u0 = acc[ai][1][m][0], u1 = acc[ai][1][m][1];
#pragma unroll
                    for (int j = 0; j < 4; ++j) { g0[j] = g0[j] * sigm_fast(g0[j]) * u0[j] * w[ai][m]; g1[j] = g1[j] * sigm_fast(g1[j]) * u1[j] * w[ai][m]; }
                    *(u32x4*)(HB + ((size_t)sb + rr) * DEXP + f) = pack8(g0, g1);
                }
            }
    }
};
struct MoeOrderD {
    const LAS MoeTab* T; const char* HBp; const char* WD; int x, NX, d0, ds, d1;
    __device__ __forceinline__ bool next(int i, pg8::Unit& u) const {
        const int du = d0 + i * ds; if (du >= d1) return false;
        int e, pm; moe_local_tile(T, x, NX, du >> 2, e, pm);
        u.pm = pm; u.pn = du & 3; u.x0 = e; u.x1 = __builtin_amdgcn_readfirstlane(T->cn[e]);
        u.A = HBp + ((size_t)__builtin_amdgcn_readfirstlane(T->sb[e]) + (size_t)pm * 256) * (DEXP * 2); u.B = WD + ((size_t)e * D + (size_t)u.pn * 256) * (DEXP * 2); return true;
    }
};
struct EpiMoeD {
    static constexpr bool PERM = true;
    static constexpr bool HAS_PRE = true;
    const int* LIST; bf16* O2;
    int pr[2][4];
    __device__ __forceinline__ void pre(const pg8::Unit& u, int wr, int wc, int fr, int fq) {
#pragma unroll
        for (int ai = 0; ai < 2; ++ai)
#pragma unroll
            for (int m = 0; m < 4; ++m) { const int rr = u.pm * 256 + ai * 128 + wr * 64 + m * 16 + fr; pr[ai][m] = (rr < u.x1) ? LIST[(size_t)u.x0 * LCAP + rr] : 0; }
    }
    __device__ __forceinline__ void operator()(AccRef acc, const pg8::Unit& u, int wr, int wc, int fr, int fq) {
        asm volatile("" : "+v"(fr), "+v"(fq));
        const int cnt = u.x1;
#pragma unroll
        for (int ai = 0; ai < 2; ++ai)
#pragma unroll
            for (int m = 0; m < 4; ++m) {
                const int rr = u.pm * 256 + ai * 128 + wr * 64 + m * 16 + fr;
                if (rr < cnt) {
#pragma unroll
                    for (int bj = 0; bj < 2; ++bj) {
                        const int c = u.pn * 256 + bj * 128 + wc * 32 + 8 * fq;
                        *(u32x4*)(O2 + (size_t)pr[ai][m] * D + c) = pack8(acc[ai][bj][m][0], acc[ai][bj][m][1]);
                    }
                }
            }
    }
};

typedef __attribute__((address_space(4))) const unsigned char* kaptr_t;
__device__ __forceinline__ kaptr_t ka_base() { kaptr_t p = (kaptr_t)__builtin_amdgcn_kernarg_segment_ptr(); asm volatile("" : "+s"(p)); return p; }
#define KIN(k) (*(const float* const __attribute__((address_space(4)))*)(ka + 8 * (k)))

typedef float f32x16 __attribute__((ext_vector_type(16)));
typedef short s16x8 __attribute__((ext_vector_type(8)));
constexpr int AT_KSTR = 272, AT_VSTR = 520, AT_VOFF = 256 * AT_KSTR;
__device__ __forceinline__ void attn_phase(LAS unsigned char* lds, const int wv, const bf16* QB, const bf16* KBl, const bf16* VTl, bf16* YMEM, const int G, const int bid) {
    const int tid = opaque_tid(wv), lane = tid & 63, r = lane & 31, hh = lane >> 5;
    for (int u = bid; u < 256; u += G) {
        const int panel = (u & 7) * 8 + (u >> 5), hd = (u >> 3) & 3, b = panel >> 5, tile = panel & 31;
        const bf16* kg = KBl + ((size_t)b * 4 + hd) * 256 * 128; const bf16* vg = VTl + ((size_t)b * 4 + hd) * 128 * 256;
        const size_t tok = (size_t)b * SEQ + (size_t)tile * 256 + wv * 32 + r;
        s16x8 qf[8];
#pragma unroll
        for (int ks = 0; ks < 8; ++ks) qf[ks] = *(const s16x8*)(QB + tok * 512 + hd * 128 + 16 * ks + 8 * hh);
        __syncthreads();
        {
            u32x4 kw[8], vw[8];
            const int rot = (u >> 3) * 128;
#pragma unroll
            for (int k = 0; k < 8; ++k) { const int i = (tid + k * NT + rot) & 4095; kw[k] = *(const u32x4*)(kg + (size_t)i * 8); vw[k] = *(const u32x4*)(vg + (size_t)i * 8); }
#pragma unroll
            for (int k = 0; k < 8; ++k) { const int i = (tid + k * NT + rot) & 4095; *(LAS u32x4*)(lds + (i >> 4) * AT_KSTR + (i & 15) * 16) = kw[k]; }
#pragma unroll
            for (int k = 0; k < 8; ++k) { const int i = (tid + k * NT + rot) & 4095; LAS u32x2* d = (LAS u32x2*)(lds + AT_VOFF + (i >> 5) * AT_VSTR + (i & 31) * 16); d[0] = (u32x2){vw[k].x, vw[k].y}; d[1] = (u32x2){vw[k].z, vw[k].w}; }
        }
        __syncthreads();
        f32x16 acc[8];
#pragma unroll
        for (int mt = 0; mt < 8; ++mt)
#pragma unroll
            for (int i = 0; i < 16; ++i) acc[mt][i] = 0.f;
#pragma unroll
        for (int ks = 0; ks < 8; ++ks) {
            s16x8 a[8];
#pragma unroll
            for (int mt = 0; mt < 8; ++mt) a[mt] = *(const LAS s16x8*)(lds + (32 * mt + r) * AT_KSTR + (16 * ks + 8 * hh) * 2);
#pragma unroll
            for (int mt = 0; mt < 8; ++mt) acc[mt] = __builtin_amdgcn_mfma_f32_32x32x16_bf16(a[mt], qf[ks], acc[mt], 0, 0, 0);
        }
        float mx = -3.0e38f;
#pragma unroll
        for (int mt = 0; mt < 8; ++mt)
#pragma unroll
            for (int i = 0; i < 16; ++i) mx = fmaxf(mx, acc[mt][i]);
        mx = fmaxf(mx, lane_xor(mx, lane, 32));
        const float C2 = 0.08838834764831845f * 1.4426950408889634f;
        float sum = 0.f;
#pragma unroll
        for (int mt = 0; mt < 8; ++mt)
#pragma unroll
            for (int i = 0; i < 16; ++i) { const float p = __builtin_amdgcn_exp2f((acc[mt][i] - mx) * C2); acc[mt][i] = p; sum += p; }
        sum += lane_xor(sum, lane, 32);
        const float inv = 1.f / sum;
        __syncthreads();
        f32x16 o[4];
#pragma unroll
        for (int dt = 0; dt < 4; ++dt)
#pragma unroll
            for (int i = 0; i < 16; ++i) o[dt][i] = 0.f;
#pragma unroll
        for (int mt = 0; mt < 8; ++mt)
#pragma unroll
            for (int s = 0; s < 2; ++s) {
                u32x4 pw; pw.x = pk2(acc[mt][8 * s + 0], acc[mt][8 * s + 1]); pw.y = pk2(acc[mt][8 * s + 2], acc[mt][8 * s + 3]);
                pw.z = pk2(acc[mt][8 * s + 4], acc[mt][8 * s + 5]); pw.w = pk2(acc[mt][8 * s + 6], acc[mt][8 * s + 7]);
                const s16x8 pb = __builtin_bit_cast(s16x8, pw);
#pragma unroll
                for (int dt = 0; dt < 4; ++dt) {
                    const LAS unsigned char* base = lds + AT_VOFF + (32 * dt + r) * AT_VSTR + (32 * mt + 16 * s + 4 * hh) * 2;
                    const u32x2 lo = *(const LAS u32x2*)base, hi = *(const LAS u32x2*)(base + 16);
                    const u32x4 aw = (u32x4){lo.x, lo.y, hi.x, hi.y};
                    o[dt] = __builtin_amdgcn_mfma_f32_32x32x16_bf16(__builtin_bit_cast(s16x8, aw), pb, o[dt], 0, 0, 0);
                }
            }
        LAS unsigned char* ob = lds + wv * (32 * 264);
#pragma unroll
        for (int dt = 0; dt < 4; ++dt)
#pragma unroll
            for (int g4 = 0; g4 < 4; ++g4) {
                u32x2 w; w.x = pk2(o[dt][4 * g4] * inv, o[dt][4 * g4 + 1] * inv); w.y = pk2(o[dt][4 * g4 + 2] * inv, o[dt][4 * g4 + 3] * inv);
                *(LAS u32x2*)(ob + r * 264 + (32 * dt + 8 * g4 + 4 * hh) * 2) = w;
            }
        asm volatile("s_waitcnt lgkmcnt(0)" ::: "memory");
        const size_t tok0 = (size_t)b * SEQ + (size_t)tile * 256 + wv * 32;
#pragma unroll
        for (int k = 0; k < 8; ++k) {
            const int p = lane + 64 * k, t = p >> 4, c16 = p & 15;
            const u32x2 lo = *(const LAS u32x2*)(ob + t * 264 + c16 * 16), hi = *(const LAS u32x2*)(ob + t * 264 + c16 * 16 + 8);
            *(u32x4*)(YMEM + (tok0 + t) * 512 + hd * 128 + c16 * 8) = (u32x4){lo.x, lo.y, hi.x, hi.y};
        }
    }
    __syncthreads();
}

constexpr int GM_STR = 272;
__device__ __forceinline__ void gmlp_phase(LAS unsigned char* lds, const int wv, const bf16* GU, const bf16* GV, const bf16* WSP, const float* b_sp, const float* gln_g, const float* gln_b,
                                           bf16* YGMLP, const int G, const int bid) {
    const int tid = opaque_tid(wv), lane = tid & 63, r = lane & 31, hh = lane >> 5;
    for (int u0 = (bid + G / 2) % G; u0 < 128; u0 += G) {
        const int u = (G == 256) ? ((u0 & 7) * 16 + (u0 >> 3)) : u0;
        const size_t t0 = (size_t)u * CHUNK;
        const int g = wv;
        const unsigned woff = (unsigned)(r * CHUNK + 8 * hh), uoff = (unsigned)((lane >> 3) * 512 + (lane & 7) * 8);
        __syncthreads();
        s16x8 bw1[8][2];
#pragma unroll
        for (int ks = 0; ks < 8; ++ks)
#pragma unroll
            for (int n2 = 0; n2 < 2; ++n2) bw1[ks][n2] = *(const s16x8*)(WSP + (size_t)(g * CHUNK + 32 * n2) * CHUNK + 16 * ks + woff);
        float gam[8], bet[8];
#pragma unroll
        for (int e = 0; e < 8; ++e) { gam[e] = gln_g[lane + 64 * e]; bet[e] = gln_b[lane + 64 * e]; }
        for (int jb = 0; jb < 4; ++jb) {
            const int j0 = wv * 16 + jb * 4;
            float v[4][8]; float s[4], q[4];
#pragma unroll
            for (int k = 0; k < 4; ++k)
#pragma unroll
                for (int e = 0; e < 8; ++e) v[k][e] = bf2f(GV[(t0 + j0 + k) * 512 + lane + 64 * e]);
#pragma unroll
            for (int k = 0; k < 4; ++k) { s[k] = 0.f;
#pragma unroll
                for (int e = 0; e < 8; ++e) s[k] += v[k][e]; }
#pragma unroll
            for (int k = 0; k < 4; ++k) s[k] = wave_sum(s[k], lane) * (1.f / 512.f);
#pragma unroll
            for (int k = 0; k < 4; ++k) { q[k] = 0.f;
#pragma unroll
                for (int e = 0; e < 8; ++e) { v[k][e] -= s[k]; q[k] += v[k][e] * v[k][e]; } }
#pragma unroll
            for (int k = 0; k < 4; ++k) q[k] = rsqrtf(wave_sum(q[k], lane) * (1.f / 512.f) + LN_EPS);
#pragma unroll
            for (int k = 0; k < 4; k += 2)
#pragma unroll
                for (int e = 0; e < 8; ++e)
                    *(LAS unsigned*)(lds + (lane + 64 * e) * GM_STR + (j0 + k) * 2) = pk2(v[k][e] * q[k] * gam[e] + bet[e], v[k + 1][e] * q[k + 1] * gam[e] + bet[e]);
        }
        __syncthreads();
        s16x8 bw2[8][2];
#pragma unroll
        for (int ks = 0; ks < 8; ++ks)
#pragma unroll
            for (int n2 = 0; n2 < 2; ++n2) bw2[ks][n2] = *(const s16x8*)(WSP + (size_t)(g * CHUNK + 64 + 32 * n2) * CHUNK + 16 * ks + woff);
        f32x16 acc[2][4];
#pragma unroll
        for (int mt = 0; mt < 2; ++mt)
#pragma unroll
            for (int nt = 0; nt < 2; ++nt)
#pragma unroll
                for (int i = 0; i < 16; ++i) acc[mt][nt][i] = 0.f;
#pragma unroll
        for (int ks = 0; ks < 8; ++ks) {
            s16x8 a[2];
#pragma unroll
            for (int mt = 0; mt < 2; ++mt) a[mt] = *(const LAS s16x8*)(lds + (g * 64 + 32 * mt + r) * GM_STR + (16 * ks + 8 * hh) * 2);
#pragma unroll
            for (int mt = 0; mt < 2; ++mt)
#pragma unroll
                for (int n2 = 0; n2 < 2; ++n2) acc[mt][n2] = __builtin_amdgcn_mfma_f32_32x32x16_bf16(a[mt], bw1[ks][n2], acc[mt][n2], 0, 0, 0);
        }
        __builtin_amdgcn_sched_barrier(0);
#pragma unroll
        for (int mt = 0; mt < 2; ++mt)
#pragma unroll
            for (int nt = 2; nt < 4; ++nt)
#pragma unroll
                for (int i = 0; i < 16; ++i) acc[mt][nt][i] = 0.f;
#pragma unroll
        for (int ks = 0; ks < 8; ++ks) {
            s16x8 a[2];
#pragma unroll
            for (int mt = 0; mt < 2; ++mt) a[mt] = *(const LAS s16x8*)(lds + (g * 64 + 32 * mt + r) * GM_STR + (16 * ks + 8 * hh) * 2);
#pragma unroll
            for (int mt = 0; mt < 2; ++mt)
#pragma unroll
                for (int n2 = 0; n2 < 2; ++n2) acc[mt][2 + n2] = __builtin_amdgcn_mfma_f32_32x32x16_bf16(a[mt], bw2[ks][n2], acc[mt][2 + n2], 0, 0, 0);
        }
        LAS unsigned char* sl = lds + (g * 64) * GM_STR;
        asm volatile("s_waitcnt lgkmcnt(0)" ::: "memory");
#pragma unroll
        for (int nt = 0; nt < 4; ++nt) {
            const int i = 32 * nt + r; const float bias = b_sp[g * CHUNK + i];
#pragma unroll
            for (int mt = 0; mt < 2; ++mt)
#pragma unroll
                for (int g4 = 0; g4 < 4; ++g4) {
                    u32x2 w; w.x = pk2(acc[mt][nt][4 * g4] + bias, acc[mt][nt][4 * g4 + 1] + bias); w.y = pk2(acc[mt][nt][4 * g4 + 2] + bias, acc[mt][nt][4 * g4 + 3] + bias);
                    *(LAS u32x2*)(sl + i * 136 + (32 * mt + 8 * g4 + 4 * hh) * 2) = w;
                }
        }
        asm volatile("s_waitcnt lgkmcnt(0)" ::: "memory");
        u32x4 uu[16];
#pragma unroll
        for (int k = 0; k < 16; ++k) uu[k] = *(const u32x4*)(GU + (t0 + 8 * k) * 512 + g * 64 + uoff);
#pragma unroll
        for (int k = 0; k < 16; ++k) {
            const int p = lane + 64 * k, pos = p >> 3, c8 = p & 7;
            const u32x2 lo = *(const LAS u32x2*)(sl + pos * 136 + c8 * 16), hi = *(const LAS u32x2*)(sl + pos * 136 + c8 * 16 + 8);
            u32x4 w;
            w.x = pk2(bflo(uu[k].x) * bflo(lo.x), bfhi(uu[k].x) * bfhi(lo.x)); w.y = pk2(bflo(uu[k].y) * bflo(lo.y), bfhi(uu[k].y) * bfhi(lo.y));
            w.z = pk2(bflo(uu[k].z) * bflo(hi.x), bfhi(uu[k].z) * bfhi(hi.x)); w.w = pk2(bflo(uu[k].w) * bflo(hi.y), bfhi(uu[k].w) * bfhi(hi.y));
            *(u32x4*)(YGMLP + (t0 + 8 * k) * 512 + g * 64 + uoff) = w;
        }
    }
    __syncthreads();
}

__device__ __forceinline__ void transpose_item(const float* W, int ldw, int k0, int n0, bf16* WT, int ldt, int drow0, LAS float* scr, int lane) {
    const int kr = lane >> 3, n4 = (lane & 7) * 4;
    f32x4 v[8];
#pragma unroll
    for (int i = 0; i < 8; ++i) v[i] = *(const f32x4*)(W + (size_t)(k0 + 8 * i + kr) * ldw + n0 + n4);
#pragma unroll
    for (int i = 0; i < 8; ++i) { LAS float* d = scr + (8 * i + kr) * 33 + n4; d[0] = v[i].x; d[1] = v[i].y; d[2] = v[i].z; d[3] = v[i].w; }
    asm volatile("s_waitcnt lgkmcnt(0)" ::: "memory");
    const int c = lane & 7;
#pragma unroll
    for (int j = 0; j < 4; ++j) { const int n = (lane >> 3) + 8 * j; const LAS float* s = scr + (8 * c) * 33 + n;
        u32x4 o; o.x = pk2(s[0 * 33], s[1 * 33]); o.y = pk2(s[2 * 33], s[3 * 33]); o.z = pk2(s[4 * 33], s[5 * 33]); o.w = pk2(s[6 * 33], s[7 * 33]);
        *(u32x4*)(WT + (size_t)(drow0 + n) * ldt + k0 + 8 * c) = o; }
    asm volatile("s_waitcnt lgkmcnt(0)" ::: "memory");
}
constexpr size_t WE_CAT = 0;
constexpr size_t WE_GLU = WE_CAT + (size_t)5120 * 1024;
constexpr size_t WE_BR = WE_GLU + (size_t)512 * 512;
constexpr size_t WE_OUT = WE_BR + (size_t)3 * 1024 * 512;
constexpr size_t WE_SP = WE_OUT + (size_t)1024 * 1024;
constexpr size_t WL_GU = 0;
constexpr size_t WL_D = WL_GU + (size_t)32 * 512 * 1024;
constexpr int CV_IN = 16 * 64, CV_GATE = 16 * 96, CV_GLU = 8 * 16, CV_BR = 8 * 32, CV_OUT = 16 * 32, CV_EG = 16 * 8, CV_ED = 4 * 32;
constexpr int CV_EARLY = CV_IN + CV_GATE + CV_GLU + 3 * CV_BR + CV_OUT, CV_LATE = 32 * CV_EG * 2 + 32 * CV_ED;
__device__ __forceinline__ void convert_early_item(const kaptr_t ka, int l, bf16* WE, int it, LAS float* scr, int lane) {
    int r = it;
    if (r < CV_IN) { transpose_item(KIN(2) + (size_t)l * D * INW, INW, (r / 64) * 64, (r % 64) * 32, WE + WE_CAT, D, (r % 64) * 32, scr, lane); return; } r -= CV_IN;
    if (r < CV_GATE) { transpose_item(KIN(3) + (size_t)l * D * NGATE, NGATE, (r / 96) * 64, (r % 96) * 32, WE + WE_CAT, D, 2048 + (r % 96) * 32, scr, lane); return; } r -= CV_GATE;
    if (r < CV_GLU) { transpose_item(KIN(13) + (size_t)l * 512 * 512, 512, (r / 16) * 64, (r % 16) * 32, WE + WE_GLU, 512, (r % 16) * 32, scr, lane); return; } r -= CV_GLU;
    if (r < 3 * CV_BR) { const int b = r / CV_BR, q = r % CV_BR; transpose_item(KIN(20) + ((size_t)l * 3 + b) * 512 * D, D, (q / 32) * 64, (q % 32) * 32, WE + WE_BR + (size_t)b * 1024 * 512, 512, (q % 32) * 32, scr, lane); return; } r -= 3 * CV_BR;
    transpose_item(KIN(21) + (size_t)l * D * D, D, (r / 32) * 64, (r % 32) * 32, WE + WE_OUT, D, (r % 32) * 32, scr, lane);
}
__device__ __forceinline__ void convert_late_item(const kaptr_t ka, int l, bf16* WL, int it, LAS float* scr, int lane) {
    int r = it;
    if (r < 64 * CV_EG) { const int sel = r / (32 * CV_EG), q0 = r % (32 * CV_EG), e = q0 / CV_EG, q = q0 % CV_EG; const int n0 = (q % 8) * 32;
        transpose_item(KIN(28 + sel) + ((size_t)l * 32 + e) * D * DEXP, DEXP, (q / 8) * 64, n0, WL + WL_GU + (size_t)e * 512 * 1024, D, (n0 >> 7) * 256 + sel * 128 + (n0 & 127), scr, lane); return; } r -= 64 * CV_EG;
    { const int e = r / CV_ED, q = r % CV_ED; transpose_item(KIN(30) + ((size_t)l * 32 + e) * DEXP * D, D, (q / 32) * 64, (q % 32) * 32, WL + WL_D + (size_t)e * 1024 * 256, DEXP, (q % 32) * 32, scr, lane); }
}
__device__ __forceinline__ void convert_early_share(const kaptr_t ka, int l, bf16* WE, int it0, int step, LAS float* scr, int lane) {
    for (int it = it0; it < CV_EARLY; it += step) convert_early_item(ka, l, WE, it, scr, lane);
    const f32x4* wsp = (const f32x4*)(KIN(17) + (size_t)l * GG * CHUNK * CHUNK);
    for (int i = it0 * 64 + lane; i < GG * CHUNK * CHUNK / 4; i += step * 64) { const f32x4 v = wsp[i]; u32x2 w; w.x = pk2(v.x, v.y); w.y = pk2(v.z, v.w); ((u32x2*)(WE + WE_SP))[i] = w; }
}
#define PHASE_IDS() const int tid = opaque_tid(wv), lane = tid & 63, wave = __builtin_amdgcn_readfirstlane(tid >> 6); (void)lane; (void)wave
#define PHASE_PTRS() \
    int bid_l = bid; asm volatile("" : "+s"(bid_l)); (void)bid_l; \
    const kaptr_t ka = ka_base(); unsigned char* ws = *(unsigned char* const __attribute__((address_space(4)))*)(ka + 272); \
    unsigned* ctl = (unsigned*)(ws + WS_CTL); float* X32 = (float*)(ws + WS_X32); bf16* XB = (bf16*)(ws + WS_XB); \
    float* Z1 = (float*)(ws + WS_Z1); bf16* X1B = (bf16*)(ws + WS_X1B); \
    bf16* UG = (bf16*)(ws + WS_AEXT); bf16* GU = (bf16*)(ws + WS_GU); bf16* GV = (bf16*)(ws + WS_GV); bf16* QB = (bf16*)(ws + WS_Q); \
    bf16* GATES = (bf16*)(ws + WS_GATES); \
    bf16* YS = (bf16*)(ws + WS_YS); bf16* YSSM = (bf16*)(ws + WS_YSSM); bf16* YGMLP = (bf16*)(ws + WS_YGMLP); bf16* YMEM = (bf16*)(ws + WS_YMEM); \
    bf16* MERGED = (bf16*)(ws + WS_MERGED); bf16* T0 = (bf16*)(ws + WS_T0); bf16* T1 = (bf16*)(ws + WS_T1); \
    bf16* KB = (bf16*)(ws + WS_KB); bf16* VT = (bf16*)(ws + WS_VT); \
    bf16* HB = (bf16*)(ws + WS_HB); int* LIST = (int*)(ws + WS_LIST); float* TOKW = (float*)(ws + WS_TOKW); \
    float* YTMP = (float*)(ws + WS_YTMP); bf16* O2 = (bf16*)(ws + WS_O2); bf16* WBL = (bf16*)(ws + WS_WBL); (void)WBL; float* S5TAB = (float*)(ws + WS_S5TAB); (void)S5TAB; \
    bf16* WKVT = (bf16*)(ws + WS_GATES); bf16* MEMB = (bf16*)(ws + WS_GATES + 8 * MiB); \
    float* SST = (float*)(ws + WS_SST); bf16* S5E = (bf16*)(ws + WS_S5E); bf16* S5BT = (bf16*)(ws + WS_S5BT); float* PTAB = (float*)(ws + WS_PTAB); float* KTAB = (float*)(ws + WS_KTAB); \
    (void)SST; (void)S5E; (void)S5BT; (void)PTAB; (void)KTAB; \
    (void)ctl; (void)X32; (void)XB; (void)Z1; (void)X1B; (void)UG; (void)GU; (void)GV; (void)QB; (void)GATES; (void)YS; (void)YSSM; (void)YGMLP; (void)YMEM; \
    (void)MERGED; (void)T0; (void)T1; (void)KB; (void)VT; (void)HB; (void)LIST; (void)TOKW; (void)YTMP; (void)O2; (void)WKVT; (void)MEMB
#define PHASE_LPTRS() \
    int l = l_iter; asm volatile("" : "+s"(l)); \
    bf16* WBE = (bf16*)(ws + ((l & 1) ? WS_WBE1 : WS_WBE0)); (void)WBE; \
    const float* b_gate = KIN(4) + (size_t)l * NGATE; \
    const float* lam_re = KIN(5) + (size_t)l * 2 * SG * SP; const float* lam_im = KIN(6) + (size_t)l * 2 * SG * SP; \
    const float* log_step = KIN(7) + (size_t)l * 2 * SG; \
    const float* sb_re = KIN(8) + (size_t)l * SG * SP * SGC; const float* sb_im = KIN(9) + (size_t)l * SG * SP * SGC; \
    const float* sc_re = KIN(10) + (size_t)l * SG * SGC * SP; const float* sc_im = KIN(11) + (size_t)l * SG * SGC * SP; \
    const float* ssm_d = KIN(12) + (size_t)l * SSMW; const float* b_glu = KIN(14) + (size_t)l * SSMW; \
    const float* gln_g = KIN(15) + (size_t)l * GW; const float* gln_b = KIN(16) + (size_t)l * GW; \
    const float* w_sp = KIN(17) + (size_t)l * GG * CHUNK * CHUNK; const float* b_sp = KIN(18) + (size_t)l * GG * CHUNK; \
    const float* ln1_g = KIN(22) + (size_t)l * D; const float* ln1_b = KIN(23) + (size_t)l * D; \
    const float* w_rg = KIN(24) + (size_t)l * D * NGRP; const float* b_rg = KIN(25) + (size_t)l * NGRP; \
    const float* w_re = KIN(26) + (size_t)l * NGRP * D * EPG; const float* b_re = KIN(27) + (size_t)l * NGRP * EPG; \
    const float* ln2_g = KIN(31) + (size_t)l * D; const float* ln2_b = KIN(32) + (size_t)l * D; \
    (void)b_gate; (void)lam_re; (void)lam_im; (void)log_step; (void)sb_re; (void)sb_im; (void)sc_re; (void)sc_im; (void)ssm_d; (void)b_glu; (void)gln_g; (void)gln_b; \
    (void)w_sp; (void)b_sp; (void)ln1_g; (void)ln1_b; (void)w_rg; (void)b_rg; (void)w_re; (void)b_re; (void)ln2_g; (void)ln2_b
struct Args { const float* in[33]; float* out; unsigned char* ws; };

__global__ void __launch_bounds__(NT, 2) fwd_kernel(Args args) {
    extern __shared__ __attribute__((aligned(16))) unsigned char lds_raw[];
    float* smf = (float*)lds_raw;
    LAS unsigned char* lds = (LAS unsigned char*)lds_raw;
    const int G = gridDim.x, bid = blockIdx.x;
    const int wv = __builtin_amdgcn_readfirstlane((int)threadIdx.x >> 6);
    if (threadIdx.x < 64) ((LAS unsigned*)(lds + LDS_MISC))[threadIdx.x] = 0u;
    __syncthreads();
    XcdBarrier bar = xcd_barrier_post((unsigned*)(args.ws + WS_CTL) + CW_BAR, (volatile LAS unsigned*)(lds + LDS_MISC));
#define GRID_BAR() do { const int t_ = opaque_tid(wv); xcd_barrier(bar, t_ == 0); } while (0)
    LAS MoeTab* mtab = (LAS MoeTab*)(lds + LDS_MISC + 256);
    const int NGW = G * 8;

    {
        PHASE_IDS(); PHASE_PTRS(); const int gw = bid * 8 + wave; LAS float* cscr = (LAS float*)(lds + wave * 16384);
        const float* x_in = KIN(0); const float* mem = KIN(1);
        const size_t n4 = (size_t)M * D / 4;
        for (size_t i0 = (size_t)bid * NT + tid; i0 < n4; i0 += (size_t)G * NT * 8) {
            f32x4 v[8];
#pragma unroll
            for (int k = 0; k < 8; ++k) { const size_t i = i0 + (size_t)k * G * NT; v[k] = (i < n4) ? ((const f32x4*)x_in)[i] : (f32x4){0.f, 0.f, 0.f, 0.f}; }
#pragma unroll
            for (int k = 0; k < 8; ++k) { const size_t i = i0 + (size_t)k * G * NT; if (i < n4) { u32x2 w; w.x = pk2(v[k].x, v[k].y); w.y = pk2(v[k].z, v[k].w); ((u32x2*)XB)[i] = w; } }
        }
        const size_t m4 = (size_t)BATCH * NMEM * D / 4;
        for (size_t i = (size_t)bid * NT + tid; i < m4; i += (size_t)G * NT) {
            const f32x4 v = ((const f32x4*)mem)[i];
            u32x2 w; w.x = pk2(v.x, v.y); w.y = pk2(v.z, v.w);
            ((u32x2*)MEMB)[i] = w;
        }
        for (int i = bid * NT + tid; i < DEPTH * 2 * SG * SP; i += G * NT) {
            const float lr = KIN(5)[i], li = KIN(6)[i], st = expf(KIN(7)[i >> 6]);
            const float mag = expf(lr * st), lbr = mag * cosf(li * st), lbi = mag * sinf(li * st);
            const float nr = lbr - 1.f, ni = lbi, den = lr * lr + li * li;
            float pr = 1.f, pi = 0.f; float* pt = PTAB + (size_t)i * 34;
#pragma unroll 1
            for (int k = 0; k <= TCH; ++k) { pt[2 * k] = pr; pt[2 * k + 1] = pi; const float t = pr * lbr - pi * lbi; pi = pr * lbi + pi * lbr; pr = t; }
            *(f32x4*)(S5TAB + (size_t)i * 8) = (f32x4){lbr, lbi, (nr * lr + ni * li) / den, (ni * lr - nr * li) / den};
            *(f32x4*)(S5TAB + (size_t)i * 8 + 4) = (f32x4){pt[2 * TCH], pt[2 * TCH + 1], 0.f, 0.f};
        }
        for (int it = gw; it < DEPTH * 512; it += NGW) { const int l = it / 512, q = it % 512;
            transpose_item(KIN(19) + (size_t)l * D * 1024, 1024, (q / 32) * 64, (q % 32) * 32, WKVT + (size_t)l * 1024 * 1024, 1024, (q % 32) * 32, cscr, lane); }
    }
    GRID_BAR();
    {
        struct KVOrder { const char* A; const char* B; int G, c;
            __device__ __forceinline__ bool next(int i, pg8::Unit& u) const { const int L = i * G + c; if (L >= 32) return false;
                u.x0 = L >> 3; u.pm = (L >> 2) & 1; u.pn = L & 3; u.x1 = 0; u.A = A + (size_t)u.pm * 256 * 2048; u.B = B + ((size_t)u.x0 * 1024 + (size_t)u.pn * 256) * 2048; return true; } };
        PHASE_PTRS();
        KVOrder S{(const char*)MEMB, (const char*)WKVT, G, bid_l};
        EpiKV E{KB, VT};
        pg8::gemm_phase<EpiKV, KVOrder>(lds, wv, 1024, 1024, 1024, S, E);
    }
    {
        PHASE_IDS(); PHASE_PTRS();
        float* sP = smf;
        float* sC = smf + 2048;
        float* sX = smf + 4096;
        for (int item = bid_l; item < DEPTH * SG * 2; item += G) {
            const int d = item & 1, g = (item >> 1) & 31, l = item >> 6;
            __syncthreads();
            for (int i = tid; i < 1024; i += NT) {
                const int p = i >> 4, k = i & 15; const size_t ti = (size_t)((l * 2 + d) * SG + g) * SP + p;
                sP[i * 2] = PTAB[ti * 34 + 2 * k]; sP[i * 2 + 1] = PTAB[ti * 34 + 2 * k + 1];
                const float fr = S5TAB[ti * 8 + 2], fi = S5TAB[ti * 8 + 3];
                const float br = KIN(8)[((size_t)(l * SG + g) * 64 + p) * 16 + k], bi = KIN(9)[((size_t)(l * SG + g) * 64 + p) * 16 + k];
                sX[i * 2] = fr * br - fi * bi; sX[i * 2 + 1] = fr * bi + fi * br;
                const int h = i >> 6, pp = i & 63;
                sC[i * 2] = KIN(10)[((size_t)(l * SG + g) * 16 + h) * 64 + pp]; sC[i * 2 + 1] = KIN(11)[((size_t)(l * SG + g) * 16 + h) * 64 + pp];
            }
            __syncthreads();
            {
                const int hh = tid & 1, h = (tid >> 1) & 15, tau = tid >> 5;
                float acc[8];
#pragma unroll
                for (int j = 0; j < 8; ++j) acc[j] = 0.f;
                for (int p = 0; p < 64; ++p) {
                    const float cr = sC[(h * 64 + p) * 2], ci = sC[(h * 64 + p) * 2 + 1], pr = sP[(p * 16 + tau) * 2], pi = sP[(p * 16 + tau) * 2 + 1];
                    const float wr = cr * pr - ci * pi, wi = cr * pi + ci * pr;
#pragma unroll
                    for (int j = 0; j < 8; ++j) acc[j] += wr * sX[(p * 16 + hh * 8 + j) * 2] - wi * sX[(p * 16 + hh * 8 + j) * 2 + 1];
                }
                float* o = KTAB + ((((size_t)(l * SG + g) * 2 + d) * TCH + tau) * 16 + h) * 16 + hh * 8;
                *(f32x4*)o = (f32x4){acc[0], acc[1], acc[2], acc[3]}; *(f32x4*)(o + 4) = (f32x4){acc[4], acc[5], acc[6], acc[7]};
            }
        }
        __syncthreads();
    }
    GRID_BAR();
    {
        PHASE_IDS(); PHASE_PTRS();
        const int NE = DEPTH * SG * 256 * 32, NB = DEPTH * SG * 256 * 64;
#pragma unroll 4
        for (int it = bid * NT + tid; it < NE; it += G * NT) {
            float v[8];
            {
                const int kg = it & 31, n = (it >> 5) & 255, g = (it >> 13) & 31, l = it >> 18;
                const int k0 = kg * 8, sp = k0 >> 4, h0 = k0 & 15, d = n >> 7, ri = (n >> 6) & 1, p = n & 63;
                const size_t ti = (size_t)((l * 2 + d) * SG + g) * SP + p;
                const int e = (d == 0) ? (TCH - 1 - sp) : sp;
                const float pr = PTAB[ti * 34 + 2 * e], pi = PTAB[ti * 34 + 2 * e + 1], fr = S5TAB[ti * 8 + 2], fi = S5TAB[ti * 8 + 3];
                const float xr = pr * fr - pi * fi, xi = pr * fi + pi * fr;
                const float* br = KIN(8) + ((size_t)(l * SG + g) * 64 + p) * 16 + h0; const float* bi = KIN(9) + ((size_t)(l * SG + g) * 64 + p) * 16 + h0;
#pragma unroll
                for (int j = 0; j < 8; ++j) v[j] = ri ? (xr * bi[j] + xi * br[j]) : (xr * br[j] - xi * bi[j]);
                u32x4 w; w.x = pk2(v[0], v[1]); w.y = pk2(v[2], v[3]); w.z = pk2(v[4], v[5]); w.w = pk2(v[6], v[7]);
                *(u32x4*)(S5E + ((size_t)(l * SG + g) * 256 + n) * 256 + k0) = w;
            }
        }
#pragma unroll 4
        for (int it = NE + bid * NT + tid; it < NE + NB; it += G * NT) {
            float v[8];
            {
                const int r = it - NE, kg = r & 63, n = (r >> 6) & 255, g = (r >> 14) & 31, l = r >> 19;
                const int k0 = kg * 8, s = n >> 4, h = n & 15;
                if (k0 < 256) {
                    const int sp = k0 >> 4, h0 = k0 & 15;
                    const float* kt = KTAB + (size_t)(l * SG + g) * 2 * TCH * 256;
#pragma unroll
                    for (int j = 0; j < 8; ++j) {
                        float x = 0.f;
                        if (sp <= s) x += kt[(0 * TCH + (s - sp)) * 256 + h * 16 + h0 + j];
                        if (sp >= s) x += kt[(1 * TCH + (sp - s)) * 256 + h * 16 + h0 + j];
                        if (sp == s && h0 + j == h) x += KIN(12)[(size_t)l * SSMW + g * 16 + h];
                        v[j] = x;
                    }
                } else {
                    const int jj = k0 - 256, d = jj >> 7, ri = (jj >> 6) & 1, p0 = jj & 63;
                    const int e = (d == 0) ? (s + 1) : (TCH - s);
                    const float* cre = KIN(10) + ((size_t)(l * SG + g) * 16 + h) * 64 + p0; const float* cim = KIN(11) + ((size_t)(l * SG + g) * 16 + h) * 64 + p0;
#pragma unroll
                    for (int j = 0; j < 8; ++j) {
                        const size_t ti = (size_t)((l * 2 + d) * SG + g) * SP + p0 + j;
                        const float pr = PTAB[ti * 34 + 2 * e], pi = PTAB[ti * 34 + 2 * e + 1], cr = cre[j], ci = cim[j];
                        v[j] = ri ? -(cr * pi + ci * pr) : (cr * pr - ci * pi);
                    }
                }
                u32x4 w; w.x = pk2(v[0], v[1]); w.y = pk2(v[2], v[3]); w.z = pk2(v[4], v[5]); w.w = pk2(v[6], v[7]);
                *(u32x4*)(S5BT + ((size_t)(l * SG + g) * 256 + n) * 512 + k0) = w;
            }
        }
        __syncthreads();
        convert_early_share(ka, 0, (bf16*)(ws + WS_WBE0), bid * 8 + wave, G * 8, (LAS float*)(lds + wave * 16384), lane);
    }
    GRID_BAR();

#pragma unroll 1
    for (int l_iter = 0; l_iter < DEPTH; ++l_iter) {
        {
            PHASE_PTRS(); PHASE_LPTRS();
            pg8::DenseOrder S; S.init(XB, WBE + WE_CAT, M, 5120, D, D, G, bid_l);
            EpiP1 E{UG, GU, GV, QB, GATES, b_gate};
            pg8::gemm_phase<EpiP1, pg8::DenseOrder>(lds, wv, D, D, D, S, E);
        }
        GRID_BAR();

#if defined(S5_NAIVE)
        { PHASE_PTRS(); PHASE_LPTRS();
        for (int unit = bid; unit < BATCH * SG; unit += G) {
            PHASE_IDS();
            const int b = unit / SG, g = unit % SG;
            float* s_u = smf;
            float* s_h = smf + 1024;
            float* s_cr = smf + 1024 + 8192;
            float* s_ci = s_cr + 1024;
            for (int i = tid; i < 1024; i += NT) { s_cr[i] = sc_re[(size_t)g * 1024 + i]; s_ci[i] = sc_im[(size_t)g * 1024 + i]; }
            for (int dir = 0; dir < 2; ++dir) {
                float lbr = 0.f, lbi = 0.f; float bbr[16], bbi[16];
                {
                    const int p = lane;
                    const f32x4 tb = *(const f32x4*)(S5TAB + ((size_t)((l * 2 + dir) * SG + g) * SP + p) * 8);
                    lbr = tb.x; lbi = tb.y;
                    const float fr = tb.z, fi = tb.w;
#pragma unroll
                    for (int h = 0; h < 16; ++h) {
                        const float br = sb_re[((size_t)g * SP + p) * 16 + h], bi = sb_im[((size_t)g * SP + p) * 16 + h];
                        bbr[h] = fr * br - fi * bi; bbi[h] = fr * bi + fi * br;
                    }
                }
                float hr = 0.f, hi = 0.f;
                for (int blk = 0; blk < SEQ / 64; ++blk) {
                    const int t0 = (dir == 0) ? blk * 64 : (SEQ - 64 - blk * 64);
                    __syncthreads();
                    for (int i = tid; i < 1024; i += NT) { const int tt = i >> 4, h = i & 15; const size_t tk = (size_t)b * SEQ + t0 + tt; s_u[i] = bf2f(UG[((size_t)g * NCHK + (tk >> 4)) * 512 + (tk & 15) * 16 + h]); }
                    __syncthreads();
                    if (wave == 0) {
                        for (int s = 0; s < 64; ++s) {
                            const int tt = (dir == 0) ? s : 63 - s;
                            float ur = 0.f, ui = 0.f;
#pragma unroll
                            for (int h = 0; h < 16; ++h) { const float u = s_u[tt * 16 + h]; ur += bbr[h] * u; ui += bbi[h] * u; }
                            const float nhr = lbr * hr - lbi * hi + ur, nhi = lbr * hi + lbi * hr + ui;
                            hr = nhr; hi = nhi;
                            s_h[(tt * 64 + lane) * 2 + 0] = hr; s_h[(tt * 64 + lane) * 2 + 1] = hi;
                        }
                    }
                    __syncthreads();
#pragma unroll
                    for (int j = 0; j < 2; ++j) {
                        const int idx = tid + j * NT, tt = idx >> 4, hh = idx & 15;
                        float y = 0.f;
                        for (int p = 0; p < 64; ++p) y += s_cr[hh * 64 + p] * s_h[(tt * 64 + p) * 2] - s_ci[hh * 64 + p] * s_h[(tt * 64 + p) * 2 + 1];
                        const size_t tok = (size_t)b * SEQ + t0 + tt; const int col = g * 16 + hh;
                        if (dir == 0) YTMP[tok * 512 + col] = y;
                        else { const float yy = ssm_d[col] * s_u[tt * 16 + hh] + YTMP[tok * 512 + col] + y; YS[tok * 512 + col] = (bf16)f2bf(gelu_tanh(yy)); }
                    }
                }
            }
            __syncthreads();
        } }

#else
        {
            PHASE_PTRS(); PHASE_LPTRS();
            S5Order S{(const char*)UG, (const char*)(S5E + (size_t)l * SG * 256 * 256), (size_t)256 * 256 * 2, G, bid_l};
            EpiS5St E{SST};
            pg8::gemm_phase<EpiS5St, S5Order>(lds, wv, 512, 256, 256, S, E);
            int bidl = bid; asm volatile("" : "+s"(bidl));
            if (bidl < G / 2) {
                PHASE_IDS(); LAS float* cscr = (LAS float*)(lds + wave * 16384);
                for (int it = bid * 8 + wave; it < 6000; it += (G / 2) * 8) convert_late_item(ka, l, WBL, it, cscr, lane);
            }
            gmlp_phase(lds, wv, GU, GV, WBE + WE_SP, b_sp, gln_g, gln_b, YGMLP, G, bid_l);
        }
        GRID_BAR();
        {
            PHASE_IDS(); PHASE_PTRS(); PHASE_LPTRS();
            for (int item = bid; item < BATCH * SG * 2; item += G) {
                const int d = item & 1, g = (item >> 1) & 31, b = item >> 6, p = lane;
                const f32x4 tb = *(const f32x4*)(S5TAB + ((size_t)((l * 2 + d) * SG + g) * SP + p) * 8 + 4);
                const float ar = tb.x, ai = tb.y;
                const float* sp = SST + ((size_t)g * NCHK + (size_t)b * 512) * 256 + d * 128 + p;
                bf16* ap = UG + ((size_t)g * NCHK + (size_t)b * 512) * 512 + 256 + d * 128 + p;
                const int q0 = wave * 64;
                float hre[64], him[64];
                float hr = 0.f, hi = 0.f;
#pragma unroll
                for (int half = 0; half < 2; ++half) {
                    float sr[32], si[32];
#pragma unroll
                    for (int j = 0; j < 32; ++j) { const int q = q0 + half * 32 + j, c = d ? (511 - q) : q; sr[j] = sp[(size_t)c * 256]; si[j] = sp[(size_t)c * 256 + 64]; }
#pragma unroll
                    for (int j = 0; j < 32; ++j) { hre[half * 32 + j] = hr; him[half * 32 + j] = hi;
                        const float nr = ar * hr - ai * hi + sr[j], ni = ar * hi + ai * hr + si[j]; hr = nr; hi = ni; }
                }
                float* ex = smf + wave * 128;
                __syncthreads();
                ex[lane] = hr; ex[64 + lane] = hi;
                float a64r = ar, a64i = ai;
#pragma unroll
                for (int k = 0; k < 6; ++k) { const float t = a64r * a64r - a64i * a64i; a64i = 2.f * a64r * a64i; a64r = t; }
                __syncthreads();
                float cr = 0.f, ci = 0.f;
                for (int w2 = 0; w2 < wave; ++w2) { const float er = smf[w2 * 128 + lane], ei = smf[w2 * 128 + 64 + lane];
                    const float nr = a64r * cr - a64i * ci + er, ni = a64r * ci + a64i * cr + ei; cr = nr; ci = ni; }
                float pr = 1.f, pi = 0.f;
#pragma unroll
                for (int j = 0; j < 64; ++j) { const int q = q0 + j, c = d ? (511 - q) : q;
                    ap[(size_t)c * 512] = (bf16)f2bf(hre[j] + pr * cr - pi * ci); ap[(size_t)c * 512 + 64] = (bf16)f2bf(him[j] + pr * ci + pi * cr);
                    const float t = pr * ar - pi * ai; pi = pr * ai + pi * ar; pr = t; }
            }
            __syncthreads();
        }
#endif
#if defined(MIX_NAIVE)
        { PHASE_PTRS(); PHASE_LPTRS();
        for (int unit = bid; unit < 128 * GG; unit += G) {
            PHASE_IDS();
            const int c = unit / GG, g = unit % GG; const size_t t0 = (size_t)c * CHUNK;
            float* s_mu = smf; float* s_rs = smf + 128; float* s_vn = smf + 256;
            __syncthreads();
            for (int j = wave; j < CHUNK; j += 8) {
                const u32x4 w = *(const u32x4*)(GV + (t0 + j) * 512 + lane * 8);
                float v[8] = {bflo(w.x), bfhi(w.x), bflo(w.y), bfhi(w.y), bflo(w.z), bfhi(w.z), bflo(w.w), bfhi(w.w)};
                float s = 0.f;
#pragma unroll
                for (int i = 0; i < 8; ++i) s += v[i];
                const float mu = wave_sum(s, lane) * (1.f / 512.f);
                float q = 0.f;
#pragma unroll
                for (int i = 0; i < 8; ++i) { const float d = v[i] - mu; q += d * d; }
                const float var = wave_sum(q, lane) * (1.f / 512.f);
                if (lane == 0) { s_mu[j] = mu; s_rs[j] = rsqrtf(var + LN_EPS); }
            }
            __syncthreads();
            for (int i = tid; i < CHUNK * 64; i += NT) {
                const int j = i >> 6, d = i & 63, ch = g * 64 + d;
                s_vn[i] = (bf2f(GV[(t0 + j) * 512 + ch]) - s_mu[j]) * s_rs[j] * gln_g[ch] + gln_b[ch];
            }
            __syncthreads();
            {
                const int d = tid & 63;
                for (int k = 0; k < 16; ++k) {
                    const int i = (tid >> 6) + 8 * k;
                    const float* wrow = w_sp + ((size_t)g * CHUNK + i) * CHUNK;
                    float s = 0.f;
                    for (int j = 0; j < CHUNK; ++j) s += wrow[j] * s_vn[j * 64 + d];
                    s += b_sp[g * CHUNK + i];
                    const int ch = g * 64 + d;
                    YGMLP[(t0 + i) * 512 + ch] = (bf16)f2bf(bf2f(GU[(t0 + i) * 512 + ch]) * s);
                }
            }
        } }
        __syncthreads();

        {
            PHASE_IDS(); PHASE_PTRS(); PHASE_LPTRS();
            float* s_q = smf + wave * 512;
            float* s_p = smf + wave * 512 + 128;
            const float scale = 0.08838834764831845f;
            for (int it = bid; it < M * MH / 8; it += G) {
                const int pair = it * 8 + wave, tok = pair >> 2, h = pair & 3, b = tok / SEQ;
                const bf16* kb = KB + (((size_t)l * 2 + b) * 4 + h) * 256 * 128;
                const bf16* vt = VT + (((size_t)l * 2 + b) * 4 + h) * 128 * 256;
                { const unsigned w = *(const unsigned*)(QB + (size_t)tok * 512 + h * 128 + lane * 2); s_q[lane * 2] = bflo(w); s_q[lane * 2 + 1] = bfhi(w); }
                __syncthreads();
                float sc[4];
#pragma unroll
                for (int j = 0; j < 4; ++j) {
                    const int m = lane + 64 * j; const bf16* kr = kb + (size_t)m * 128; float s = 0.f;
                    for (int d8 = 0; d8 < 16; ++d8) {
                        const u32x4 w = *(const u32x4*)(kr + d8 * 8); const float* qq = s_q + d8 * 8;
                        s += bflo(w.x) * qq[0] + bfhi(w.x) * qq[1] + bflo(w.y) * qq[2] + bfhi(w.y) * qq[3] + bflo(w.z) * qq[4] + bfhi(w.z) * qq[5] + bflo(w.w) * qq[6] + bfhi(w.w) * qq[7];
                    }
                    sc[j] = s * scale;
                }
                const float mx = wave_max(fmaxf(fmaxf(sc[0], sc[1]), fmaxf(sc[2], sc[3])), lane);
                float ps = 0.f;
#pragma unroll
                for (int j = 0; j < 4; ++j) { sc[j] = __expf(sc[j] - mx); ps += sc[j]; }
                const float inv = 1.f / wave_sum(ps, lane);
#pragma unroll
                for (int j = 0; j < 4; ++j) s_p[lane + 64 * j] = sc[j] * inv;
                __syncthreads();
                float o[2];
#pragma unroll
                for (int j = 0; j < 2; ++j) {
                    const int d = lane * 2 + j; const bf16* vr = vt + (size_t)d * 256; float s = 0.f;
                    for (int m8 = 0; m8 < 32; ++m8) {
                        const u32x4 w = *(const u32x4*)(vr + m8 * 8); const float* pp = s_p + m8 * 8;
                        s += bflo(w.x) * pp[0] + bfhi(w.x) * pp[1] + bflo(w.y) * pp[2] + bfhi(w.y) * pp[3] + bflo(w.z) * pp[4] + bfhi(w.z) * pp[5] + bflo(w.w) * pp[6] + bfhi(w.w) * pp[7];
                    }
                    o[j] = s;
                }
                *(unsigned*)(YMEM + (size_t)tok * 512 + h * 128 + lane * 2) = pk2(o[0], o[1]);
                __syncthreads();
            }
        }
#else
        {
            PHASE_PTRS(); PHASE_LPTRS();
            attn_phase(lds, wv, QB, KB + (size_t)l * 2 * 4 * 256 * 128, VT + (size_t)l * 2 * 4 * 128 * 256, YMEM, G, bid_l);
            int bidl = bid; asm volatile("" : "+s"(bidl));
            if (bidl >= G / 2) {
                PHASE_IDS(); LAS float* cscr = (LAS float*)(lds + wave * 16384);
                for (int it = 6000 + (bid - G / 2) * 8 + wave; it < 6800; it += (G - G / 2) * 8) convert_late_item(ka, l, WBL, it, cscr, lane);
            }
        }
#endif
        GRID_BAR();
#if !defined(S5_NAIVE)
        {
            PHASE_PTRS(); PHASE_LPTRS();
            S5Order S{(const char*)UG, (const char*)(S5BT + (size_t)l * SG * 256 * 512), (size_t)256 * 512 * 2, G, bid_l};
            EpiS5Out E{YS};
            pg8::gemm_phase<EpiS5Out, S5Order>(lds, wv, 512, 512, 512, S, E);
            int bidl = bid; asm volatile("" : "+s"(bidl));
            {
                PHASE_IDS(); LAS float* cscr = (LAS float*)(lds + wave * 16384);
                if (bidl >= G / 2) { for (int it = 6800 + (bid - G / 2) * 8 + wave; it < CV_LATE; it += (G - G / 2) * 8) convert_late_item(ka, l, WBL, it, cscr, lane); }

            }
        }
        GRID_BAR();
#endif

        {
            PHASE_PTRS(); PHASE_LPTRS();
            GluOrder S{(const char*)YS, (const char*)(WBE + WE_GLU), G, bid_l};
            EpiGLU E{YS, YSSM, b_glu};
            pg8::gemm_phase<EpiGLU, GluOrder, false, 1>(lds, wv, 512, 512, 512, S, E);
        }
        GRID_BAR();
        {
            PHASE_PTRS(); PHASE_LPTRS();
            MergeOrder S{(const char*)YSSM, (const char*)YGMLP, (const char*)YMEM, (const char*)(WBE + WE_BR), G, bid_l};
            EpiMergeF E; E.GATES = GATES; E.MERGED = MERGED;
#pragma unroll
            for (int a_ = 0; a_ < 2; ++a_)
#pragma unroll
                for (int m_ = 0; m_ < 4; ++m_) { E.tot[a_][m_][0] = (f32x4){0.f, 0.f, 0.f, 0.f}; E.tot[a_][m_][1] = (f32x4){0.f, 0.f, 0.f, 0.f}; E.gv[a_][m_] = (u32x4){0u, 0u, 0u, 0u}; }
            pg8::gemm_phase<EpiMergeF, MergeOrder, false, 1>(lds, wv, 512, 512, 512, S, E);
        }
        GRID_BAR();
        {
            PHASE_PTRS(); PHASE_LPTRS();
            pg8::DenseOrder S; S.init(MERGED, WBE + WE_OUT, M, D, D, D, G, bid_l);
            EpiOut E{XB, (bf16*)Z1};
            pg8::gemm_phase<EpiOut, pg8::DenseOrder>(lds, wv, D, D, D, S, E);
        }
        GRID_BAR();

        { PHASE_IDS(); PHASE_PTRS(); PHASE_LPTRS(); unsigned* ecnt = ctl + CW_CNT + l * 32 * 64;
        LAS unsigned* lcnt = (LAS unsigned*)(lds + LDS_MISC + 1024); LAS unsigned* lbase = lcnt + 32; LAS int* lrec = (LAS int*)(lcnt + 64);
        const int tpw = (M + G - 1) / G;
        const int vb = bid;
        __syncthreads();
        if (tid < 32) lcnt[tid] = 0u;
        for (int i0 = tid; i0 < 9216; i0 += NT) {
            int i = i0 + (bid >> 3) * 288; if (i >= 9216) i -= 9216;
            const int a = i >> 10, r = i & 1023, pr = (r & ~63) | ((r & 3) << 4) | ((r >> 2) & 15);
            const f32x4 w = (a == 0) ? *(const f32x4*)(w_rg + (size_t)r * 4) : *(const f32x4*)(w_re + ((size_t)((a - 1) >> 1) * D + r) * 8 + ((a - 1) & 1) * 4);
            *(LAS f32x4*)(lds + ((size_t)a * 1024 + pr) * 16) = w;
        }
        __syncthreads();
        const int lrow = (lane >> 4) * 64 + (lane & 15);
        for (int ti0 = wave; ti0 < tpw; ti0 += 16) {
            f32x4 v[2][4]; float s[2], q[2], lg[2][4], le[2][8], pgv[2]; int gs[2], tiv[2], tokv[2]; bool ok[2];
#pragma unroll
            for (int t = 0; t < 2; ++t) {
                tiv[t] = ti0 + 8 * t; tokv[t] = vb * tpw + tiv[t]; ok[t] = (tiv[t] < tpw) && (tokv[t] < M);
                const bf16* zr = (const bf16*)Z1 + (size_t)(ok[t] ? tokv[t] : vb * tpw) * D; s[t] = 0.f;
#pragma unroll
                for (int j = 0; j < 4; ++j) { const u32x2 zw = *(const u32x2*)(zr + j * 256 + lane * 4); v[t][j] = (f32x4){bflo(zw.x), bfhi(zw.x), bflo(zw.y), bfhi(zw.y)}; s[t] += (v[t][j].x + v[t][j].y) + (v[t][j].z + v[t][j].w); }
            }
#pragma unroll
            for (int t = 0; t < 2; ++t) s[t] = wave_sum(s[t], lane) * (1.f / D);
#pragma unroll
            for (int t = 0; t < 2; ++t) { q[t] = 0.f;
#pragma unroll
                for (int j = 0; j < 4; ++j) { v[t][j] = v[t][j] - s[t]; q[t] += (v[t][j].x * v[t][j].x + v[t][j].y * v[t][j].y) + (v[t][j].z * v[t][j].z + v[t][j].w * v[t][j].w); } }
#pragma unroll
            for (int t = 0; t < 2; ++t) q[t] = rsqrtf(wave_sum(q[t], lane) * (1.f / D) + LN_EPS);
#pragma unroll
            for (int t = 0; t < 2; ++t)
#pragma unroll
                for (int g = 0; g < 4; ++g) lg[t][g] = 0.f;
#pragma unroll
            for (int j = 0; j < 4; ++j) {
                const int c0 = j * 256 + lane * 4;
                const f32x4 gg = *(const f32x4*)(ln1_g + c0), bb = *(const f32x4*)(ln1_b + c0);
#pragma unroll
                for (int t = 0; t < 2; ++t) {
                    v[t][j] = v[t][j] * q[t] * gg + bb;
                    if (ok[t]) { u32x2 w; w.x = pk2(v[t][j].x, v[t][j].y); w.y = pk2(v[t][j].z, v[t][j].w); *(u32x2*)(X1B + (size_t)tokv[t] * D + c0) = w; }
                }
#pragma unroll
                for (int e = 0; e < 4; ++e) {
                    const f32x4 wr = *(const LAS f32x4*)(lds + (j * 256 + lrow + 16 * e) * 16);
#pragma unroll
                    for (int t = 0; t < 2; ++t) { const float xv = v[t][j][e]; lg[t][0] += xv * wr.x; lg[t][1] += xv * wr.y; lg[t][2] += xv * wr.z; lg[t][3] += xv * wr.w; }
                }
            }
#pragma unroll
            for (int t = 0; t < 2; ++t) { wave_sum4(lg[t], lane);
#pragma unroll
                for (int g = 0; g < 4; ++g) lg[t][g] += b_rg[g]; }
#pragma unroll
            for (int t = 0; t < 2; ++t) {
                int gsel = 0; float gm = lg[t][0];
#pragma unroll
                for (int g = 1; g < 4; ++g) if (lg[t][g] > gm) { gm = lg[t][g]; gsel = g; }
                float den = 0.f;
#pragma unroll
                for (int g = 0; g < 4; ++g) den += __expf(lg[t][g] - gm);
                pgv[t] = 1.f / den; gs[t] = gsel;
#pragma unroll
                for (int e = 0; e < 8; ++e) le[t][e] = 0.f;
                const LAS unsigned char* wre = lds + 16384 + gsel * 32768;
#pragma unroll
                for (int j = 0; j < 4; ++j) {
#pragma unroll
                    for (int e = 0; e < 4; ++e) {
                        const f32x4 w0 = *(const LAS f32x4*)(wre + (j * 256 + lrow + 16 * e) * 16), w1 = *(const LAS f32x4*)(wre + 16384 + (j * 256 + lrow + 16 * e) * 16);
                        const float xv = v[t][j][e];
                        le[t][0] += xv * w0.x; le[t][1] += xv * w0.y; le[t][2] += xv * w0.z; le[t][3] += xv * w0.w;
                        le[t][4] += xv * w1.x; le[t][5] += xv * w1.y; le[t][6] += xv * w1.z; le[t][7] += xv * w1.w;
                    }
                }
            }
#pragma unroll
            for (int t = 0; t < 2; ++t) { wave_sum8(le[t], lane);
#pragma unroll
                for (int e = 0; e < 8; ++e) le[t][e] += b_re[gs[t] * 8 + e]; }
#pragma unroll
            for (int t = 0; t < 2; ++t) {
                int i0 = 0; float v0 = le[t][0];
#pragma unroll
                for (int e = 1; e < 8; ++e) if (le[t][e] > v0) { v0 = le[t][e]; i0 = e; }
                int i1 = -1; float v1 = -3.0e38f;
#pragma unroll
                for (int e = 0; e < 8; ++e) if (e != i0 && le[t][e] > v1) { v1 = le[t][e]; i1 = e; }
                const float p0 = 1.f / (1.f + __expf(v1 - v0)), p1 = 1.f - p0;
                if (lane == 0 && ok[t]) {
                    const int e0 = gs[t] * 8 + i0, e1 = gs[t] * 8 + i1;
                    const unsigned q0 = __hip_atomic_fetch_add(lcnt + e0, 1u, __ATOMIC_RELAXED, __HIP_MEMORY_SCOPE_WORKGROUP), q1 = __hip_atomic_fetch_add(lcnt + e1, 1u, __ATOMIC_RELAXED, __HIP_MEMORY_SCOPE_WORKGROUP);
                    lrec[tiv[t] * 4 + 0] = e0; lrec[tiv[t] * 4 + 1] = e1; lrec[tiv[t] * 4 + 2] = (int)q0; lrec[tiv[t] * 4 + 3] = (int)q1;
                    TOKW[tokv[t] * 2] = pgv[t] * p0; TOKW[tokv[t] * 2 + 1] = pgv[t] * p1;
                }
            }
        }
        __syncthreads();
        if (tid < 32) { const unsigned n = lcnt[tid]; lbase[tid] = n ? atomicAdd(&ecnt[tid * 64], n) : 0u; }
        __syncthreads();
        for (int ti = tid; ti < tpw; ti += NT) { const int tok = vb * tpw + ti;
            if (tok < M) { const int e0 = lrec[ti * 4], e1 = lrec[ti * 4 + 1];
                LIST[(size_t)e0 * LCAP + lbase[e0] + lrec[ti * 4 + 2]] = tok * 2; LIST[(size_t)e1 * LCAP + lbase[e1] + lrec[ti * 4 + 3]] = tok * 2 + 1; } }
        __syncthreads();
        }
        GRID_BAR();

        if (opaque_tid(wv) == 0) {
            PHASE_PTRS(); PHASE_LPTRS(); unsigned* ecnt = ctl + CW_CNT + l * 32 * 64;
            int tb = 0, sb = 0;
            for (int e = 0; e < NEXP; ++e) { const int cnt = (int)xb_ld(&ecnt[e * 64]); const int nrt = (cnt + 255) >> 8; mtab->tb[e] = tb; mtab->sb[e] = sb; mtab->cn[e] = cnt; tb += nrt; sb += nrt * 256; }
            mtab->tb[32] = tb; mtab->sb[32] = sb;
        }
        __syncthreads();
        {
            PHASE_PTRS(); PHASE_LPTRS();
            const int NX = (G % 8 == 0) ? 8 : 1, Gx = G / NX, x = bid_l % NX, kx = bid_l / NX;
            const int Tx = moe_ntile_x(mtab, x, NX), NGU = 2 * Tx;
            unsigned* tcnt = ctl + CW_TC + (size_t)l * 160 * 64;
#define MOE_GU_UNIT(lu_) do { const int lu = (lu_); int e, pm; moe_local_tile(mtab, x, NX, lu >> 1, e, pm); \
                const int cnt = __builtin_amdgcn_readfirstlane(mtab->cn[e]), t = __builtin_amdgcn_readfirstlane(mtab->tb[e]) + pm; \
                MoeOrderGU S{(const char*)X1B, (const char*)(WBL + WL_GU), LIST, e, pm, cnt, lu & 1}; \
                EpiMoeGU E; E.T = mtab; E.LIST = LIST; E.TOKW = TOKW; E.HB = HB; E.init(e, pm, cnt, opaque_tid(wv)); \
                pg8::gemm_phase<EpiMoeGU, MoeOrderGU, true>(lds, wv, D, D, D, S, E); \
                  \
                if (opaque_tid(wv) == 0) { __builtin_amdgcn_fence(__ATOMIC_RELEASE, "agent"); asm volatile("s_waitcnt vmcnt(0)" ::: "memory"); (void)xb_add(&tcnt[t * 64], 1u); } } while (0)
            if (kx < NGU) MOE_GU_UNIT(kx);
#pragma unroll 1
            for (int lu2 = kx + Gx; lu2 < NGU; lu2 += Gx) MOE_GU_UNIT(lu2);
#undef MOE_GU_UNIT
            {
                const int R2 = (NGU > Gx) ? (NGU - Gx) : 0;
                int j, We;
                if (R2 < Gx) { We = Gx - R2; j = kx - R2; } else { We = Gx; j = kx; }
                const int Te = (R2 < Gx) ? ((Tx < Gx / 2) ? Tx : (Gx / 2)) : 0, NDe = 4 * Te, ND = 4 * Tx;
#define MOE_D_CALL(d0_, d1_) do { const int dd0 = (d0_), dd1 = (d1_); \
                if (j >= 0 && dd0 < dd1) { \
                    if (opaque_tid(wv) == 0) { unsigned* bw = ctl + CW_BAR; \
                        for (int du = dd0; du < dd1; du += We) { int e, pm; moe_local_tile(mtab, x, NX, du >> 2, e, pm); const int t = mtab->tb[e] + pm; XB_SPIN(xb_ld(&tcnt[t * 64]) < 2u, bw); } \
                        __builtin_amdgcn_fence(__ATOMIC_ACQUIRE, "agent"); asm volatile("s_waitcnt vmcnt(0)" ::: "memory"); } \
                    __syncthreads(); \
                    MoeOrderD S{mtab, (const char*)HB, (const char*)(WBL + WL_D), x, NX, dd0, We, dd1}; \
                    EpiMoeD E; E.LIST = LIST; E.O2 = O2; _Pragma("unroll") for (int a_ = 0; a_ < 2; ++a_) _Pragma("unroll") for (int m_ = 0; m_ < 4; ++m_) E.pr[a_][m_] = 0; \
                    pg8::gemm_phase<EpiMoeD, MoeOrderD>(lds, wv, DEXP, DEXP, DEXP, S, E); } } while (0)
                MOE_D_CALL(j, NDe);
                MOE_D_CALL(NDe + j, ND);
#undef MOE_D_CALL
            }
            if (l + 1 < DEPTH) {
                PHASE_IDS();
                convert_early_share(ka, l + 1, (bf16*)(ws + (((l + 1) & 1) ? WS_WBE1 : WS_WBE0)), bid_l * 8 + wave, G * 8, (LAS float*)(lds + wave * 16384), lane);
            }
        }
        GRID_BAR();

        { PHASE_IDS(); PHASE_PTRS(); PHASE_LPTRS();
        float* outp = *(float* const __attribute__((address_space(4)))*)(ka + 264);
        for (int tok0 = bid * 8 + wave; tok0 < M; tok0 += G * 16) {
            f32x4 v[2][4]; float s[2], q[2]; int tk[2];
#pragma unroll
            for (int t = 0; t < 2; ++t) {
                tk[t] = tok0 + t * G * 8; const int tok = (tk[t] < M) ? tk[t] : tok0; s[t] = 0.f;
                const bf16* xr = X1B + (size_t)tok * D;
#pragma unroll
                for (int j = 0; j < 4; ++j) {
                    const int c0 = j * 256 + lane * 4;
                    const u32x2 xw = *(const u32x2*)(xr + c0);
                    const u32x2 a = *(const u32x2*)(O2 + (size_t)(tok * 2) * D + c0), b = *(const u32x2*)(O2 + (size_t)(tok * 2 + 1) * D + c0);
                    v[t][j].x = ALPHA * bflo(xw.x) + bflo(a.x) + bflo(b.x); v[t][j].y = ALPHA * bfhi(xw.x) + bfhi(a.x) + bfhi(b.x);
                    v[t][j].z = ALPHA * bflo(xw.y) + bflo(a.y) + bflo(b.y); v[t][j].w = ALPHA * bfhi(xw.y) + bfhi(a.y) + bfhi(b.y);
                    s[t] += (v[t][j].x + v[t][j].y) + (v[t][j].z + v[t][j].w);
                }
            }
#pragma unroll
            for (int t = 0; t < 2; ++t) s[t] = wave_sum(s[t], lane) * (1.f / D);
#pragma unroll
            for (int t = 0; t < 2; ++t) { q[t] = 0.f;
#pragma unroll
                for (int j = 0; j < 4; ++j) { v[t][j] = v[t][j] - s[t]; q[t] += (v[t][j].x * v[t][j].x + v[t][j].y * v[t][j].y) + (v[t][j].z * v[t][j].z + v[t][j].w * v[t][j].w); } }
#pragma unroll
            for (int t = 0; t < 2; ++t) q[t] = rsqrtf(wave_sum(q[t], lane) * (1.f / D) + LN_EPS);
#pragma unroll
            for (int t = 0; t < 2; ++t) {
                if (tk[t] < M) {
#pragma unroll
                    for (int j = 0; j < 4; ++j) {
                        const int c0 = j * 256 + lane * 4;
                        const f32x4 gg = *(const f32x4*)(ln2_g + c0), bb = *(const f32x4*)(ln2_b + c0);
                        const f32x4 o = v[t][j] * q[t] * gg + bb;
                        if (l == DEPTH - 1) *(f32x4*)(outp + (size_t)tk[t] * D + c0) = o;
                        else { u32x2 w; w.x = pk2(o.x, o.y); w.y = pk2(o.z, o.w); *(u32x2*)(XB + (size_t)tk[t] * D + c0) = w; }
                    }
                }
            }
        } }
        if (l_iter != DEPTH - 1) GRID_BAR();
    }
}

extern "C" void kernel_launch(void* const* d_in, const int* in_sizes, int n_in, void* d_out, int out_size, void* d_ws, size_t ws_size, hipStream_t stream) {
    static int grid = 0;
    if (grid == 0) {
        if (n_in != 33 || out_size != M * D || ws_size < WS_END) { fprintf(stderr, "kernel_launch: unexpected shapes n_in %d out %d ws %zu (need %zu)\n", n_in, out_size, ws_size, (size_t)WS_END); grid = -1; return; }
        int dev = 0, cus = 0, per_cu = 0;
        if (hipGetDevice(&dev) != hipSuccess || hipDeviceGetAttribute(&cus, hipDeviceAttributeMultiprocessorCount, dev) != hipSuccess) { grid = -1; return; }
        if (hipFuncSetAttribute((const void*)fwd_kernel, hipFuncAttributeMaxDynamicSharedMemorySize, LDS_BYTES) != hipSuccess) { fprintf(stderr, "kernel_launch: hipFuncSetAttribute failed\n"); grid = -1; return; }
        if (hipOccupancyMaxActiveBlocksPerMultiprocessor(&per_cu, (const void*)fwd_kernel, NT, LDS_BYTES) != hipSuccess || per_cu < 1) { fprintf(stderr, "kernel_launch: occupancy query says %d\n", per_cu); per_cu = 1; }
        (void)hipGetLastError();
        grid = cus;
        if (grid < 160) { fprintf(stderr, "kernel_launch: built for a grid of >= 160 workgroups (MoE phase: one row tile per workgroup); device has %d CUs\n", cus); grid = -1; return; }
    }
    if (grid < 0) return;
    (void)hipMemsetAsync((char*)d_ws + WS_CTL, 0, CTL_ZERO_BYTES, stream);
    Args a{};
    for (int i = 0; i < 33; ++i) a.in[i] = (const float*)d_in[i];
    a.out = (float*)d_out; a.ws = (unsigned char*)d_ws;
    hipLaunchKernelGGL(fwd_kernel, dim3(grid), dim3(NT), LDS_BYTES, stream, a);
}
```

```cpp
#include <hip/hip_runtime.h>
#include <cstdio>
#include <cstdint>

#define LAS __attribute__((address_space(3)))
typedef unsigned short bf16;
typedef float f32x4 __attribute__((ext_vector_type(4)));
typedef float f32x2 __attribute__((ext_vector_type(2)));
typedef unsigned u32x4 __attribute__((ext_vector_type(4)));
typedef unsigned u32x2 __attribute__((ext_vector_type(2)));

constexpr int D = 1024, BATCH = 2, SEQ = 8192, M = BATCH * SEQ, DEPTH = 4;
constexpr int NMEM = 256, SSMW = 512, SG = 32, SGC = 16, SP = 64;
constexpr int GW = 512, GG = 8, GGC = 64, CHUNK = 128;
constexpr int MH = 4, MW = 512, MHD = 128;
constexpr int INW = 2048, NGATE = 3072;
constexpr int NGRP = 4, EPG = 8, NEXP = 32, DEXP = 256;
constexpr float ALPHA = 1.6817928305074290f;
constexpr float LN_EPS = 1e-5f;
constexpr int LCAP = 16640;
constexpr int SPCAP = 41216;

constexpr size_t MiB = 1u << 20;
constexpr size_t WS_CTL = 0, CTL_ZERO_BYTES = 1 * MiB;
constexpr size_t WS_X32 = 1 * MiB;
constexpr size_t WS_XB = 65 * MiB;
constexpr size_t WS_Z1 = 97 * MiB;
constexpr size_t WS_AEXT = 161 * MiB;
constexpr size_t WS_T0 = WS_AEXT;
constexpr size_t WS_X1B = WS_AEXT;
constexpr size_t WS_GU = 193 * MiB;
constexpr size_t WS_GV = 209 * MiB;
constexpr size_t WS_Q = 225 * MiB;
constexpr size_t WS_T1 = WS_GV;
constexpr size_t WS_GATES = 241 * MiB;
constexpr size_t WS_O2 = WS_GATES;
constexpr size_t WS_YS = 337 * MiB;
constexpr size_t WS_YSSM = 353 * MiB;
constexpr size_t WS_YGMLP = 369 * MiB;
constexpr size_t WS_YMEM = 385 * MiB;
constexpr size_t WS_MERGED = 401 * MiB;
constexpr size_t WS_SST = WS_MERGED;
constexpr size_t WS_KB = 433 * MiB;
constexpr size_t WS_VT = 435 * MiB;
constexpr size_t WS_HB = 437 * MiB;
constexpr size_t WS_LIST = 458 * MiB;
constexpr size_t WS_TOKW = 461 * MiB;
constexpr size_t WS_S5TAB = 461 * MiB + 512 * 1024;
constexpr size_t WS_WBE0 = 462 * MiB;
constexpr size_t WS_WBL = 478 * MiB;
constexpr size_t WS_WBE1 = 574 * MiB;
constexpr size_t WS_S5E = 526 * MiB;
constexpr size_t WS_S5BT = 542 * MiB;
constexpr size_t WS_END = 590 * MiB;
constexpr size_t WS_PTAB = WS_Z1;
constexpr size_t WS_KTAB = WS_Z1 + 4 * MiB;
constexpr int TCH = 16, NCHK = M / TCH;
constexpr int CW_DBG = 8;
constexpr int CW_CNT = 16384;
constexpr int CW_BAR = 4096;
constexpr int CW_TC = 65536;

__device__ __forceinline__ unsigned f2bf(float f) { unsigned u = __builtin_bit_cast(unsigned, f); return (u + 0x7fffu + ((u >> 16) & 1u)) >> 16; }
__device__ __forceinline__ float bf2f(unsigned short b) { return __builtin_bit_cast(float, (unsigned)b << 16); }
__device__ __forceinline__ float bflo(unsigned w) { return __builtin_bit_cast(float, w << 16); }
__device__ __forceinline__ float bfhi(unsigned w) { return __builtin_bit_cast(float, w & 0xffff0000u); }
__device__ __forceinline__ unsigned pk2(float lo, float hi) { return f2bf(lo) | (f2bf(hi) << 16); }
__device__ __forceinline__ float gelu_tanh(float x) { const float u = 0.7978845608028654f * (x + 0.044715f * x * x * x); return 0.5f * x * (1.f + tanhf(u)); }
__device__ __forceinline__ float sigmoidf_(float x) { return 1.f / (1.f + __expf(-x)); }
__device__ __forceinline__ float lane_xor(float v, int lane, int m) { return __builtin_bit_cast(float, __builtin_amdgcn_ds_bpermute((lane ^ m) << 2, __builtin_bit_cast(int, v))); }
__device__ __forceinline__ float wave_sum(float v, int lane) {
#pragma unroll
    for (int o = 1; o < 64; o <<= 1) v += lane_xor(v, lane, o);
    return v;
}
__device__ __forceinline__ float wave_max(float v, int lane) {
#pragma unroll
    for (int o = 1; o < 64; o <<= 1) v = fmaxf(v, lane_xor(v, lane, o));
    return v;
}

__device__ __forceinline__ void wave_sum4(float (&v)[4], int lane) {
    const bool b5 = (lane & 32) != 0, b4 = (lane & 16) != 0;
    float k0 = b5 ? v[2] : v[0], k1 = b5 ? v[3] : v[1]; const float s0 = b5 ? v[0] : v[2], s1 = b5 ? v[1] : v[3];
    k0 += lane_xor(s0, lane, 32); k1 += lane_xor(s1, lane, 32);
    float k = b4 ? k1 : k0; const float s = b4 ? k0 : k1;
    k += lane_xor(s, lane, 16);
    k += lane_xor(k, lane, 8); k += lane_xor(k, lane, 4); k += lane_xor(k, lane, 2); k += lane_xor(k, lane, 1);
    const int ki = __builtin_bit_cast(int, k);
    v[0] = __builtin_bit_cast(float, __builtin_amdgcn_readlane(ki, 0)); v[1] = __builtin_bit_cast(float, __builtin_amdgcn_readlane(ki, 16));
    v[2] = __builtin_bit_cast(float, __builtin_amdgcn_readlane(ki, 32)); v[3] = __builtin_bit_cast(float, __builtin_amdgcn_readlane(ki, 48));
}
__device__ __forceinline__ void wave_sum8(float (&v)[8], int lane) {
    const bool b5 = (lane & 32) != 0, b4 = (lane & 16) != 0, b3 = (lane & 8) != 0;
    float k[4], s[4];
#pragma unroll
    for (int i = 0; i < 4; ++i) { k[i] = b5 ? v[4 + i] : v[i]; s[i] = b5 ? v[i] : v[4 + i]; }
#pragma unroll
    for (int i = 0; i < 4; ++i) k[i] += lane_xor(s[i], lane, 32);
    float k2[2], s2[2];
#pragma unroll
    for (int i = 0; i < 2; ++i) { k2[i] = b4 ? k[2 + i] : k[i]; s2[i] = b4 ? k[i] : k[2 + i]; }
#pragma unroll
    for (int i = 0; i < 2; ++i) k2[i] += lane_xor(s2[i], lane, 16);
    float kk = b3 ? k2[1] : k2[0]; const float ss = b3 ? k2[0] : k2[1];
    kk += lane_xor(ss, lane, 8);
    kk += lane_xor(kk, lane, 4); kk += lane_xor(kk, lane, 2); kk += lane_xor(kk, lane, 1);
    const int ki = __builtin_bit_cast(int, kk);
    v[0] = __builtin_bit_cast(float, __builtin_amdgcn_readlane(ki, 0)); v[1] = __builtin_bit_cast(float, __builtin_amdgcn_readlane(ki, 8));
    v[2] = __builtin_bit_cast(float, __builtin_amdgcn_readlane(ki, 16)); v[3] = __builtin_bit_cast(float, __builtin_amdgcn_readlane(ki, 24));
    v[4] = __builtin_bit_cast(float, __builtin_amdgcn_readlane(ki, 32)); v[5] = __builtin_bit_cast(float, __builtin_amdgcn_readlane(ki, 40));
    v[6] = __builtin_bit_cast(float, __builtin_amdgcn_readlane(ki, 48)); v[7] = __builtin_bit_cast(float, __builtin_amdgcn_readlane(ki, 56));
}

#define XB_TMO      128
#define XB_XCNT(j)  (256  + 64 * (j))
#define XB_XSUB(j)  (1280 + 64 * (j))
#define XB_XGEN(j)  (2304 + 64 * (j))
#define XB_TOP      3328
#define XB_TOPGEN   3392
#define XCD_BAR_WORDS 3456
#define XB_SPIN_CAP (1u << 22)

__device__ __forceinline__ unsigned xb_ld(unsigned* p)              { return __hip_atomic_load(p, __ATOMIC_RELAXED, __HIP_MEMORY_SCOPE_AGENT); }
__device__ __forceinline__ unsigned xb_add(unsigned* p, unsigned v) { return __hip_atomic_fetch_add(p, v, __ATOMIC_RELAXED, __HIP_MEMORY_SCOPE_AGENT); }
__device__ __forceinline__ unsigned xb_xcc_id() { return (unsigned)__builtin_amdgcn_s_getreg((3 << 11) | 20) & 0xFu; }
#define XB_SPIN(cond, bar) do { unsigned _sp = 0; while (cond) { __builtin_amdgcn_s_sleep(1); \
    if ((++_sp & 255u) == 0u) { if (xb_ld(&(bar)[XB_TMO])) break; if (_sp > XB_SPIN_CAP) { atomicAdd(&(bar)[XB_TMO], 1u); break; } } } } while (0)

struct XcdBarrier { unsigned* bar; unsigned x; volatile LAS unsigned* st; };

__device__ __forceinline__ XcdBarrier xcd_barrier_post(unsigned* bar, volatile LAS unsigned* st) {
    XcdBarrier b; b.bar = bar; b.x = xb_xcc_id(); b.st = st;
    if (threadIdx.x == 0) (void)xb_add(&bar[XB_XCNT(b.x)], 1u);
    return b;
}
__device__ __forceinline__ void xcd_barrier_complete(unsigned* bar, unsigned x, unsigned& nloc, unsigned& nx) {
    const unsigned G = gridDim.x * gridDim.y * gridDim.z;
    unsigned sum, cnt, mine, sp = 0u;
    for (;;) {
        sum = 0u; cnt = 0u; mine = 0u;
#pragma unroll
        for (unsigned j = 0; j < 16; ++j) { const unsigned c = xb_ld(&bar[XB_XCNT(j)]); sum += c; cnt += (c > 0u) ? 1u : 0u; }
        mine = xb_ld(&bar[XB_XCNT(x)]);
        if (sum == G) break;
        __builtin_amdgcn_s_sleep(1);
        if ((++sp & 255u) == 0u) { if (xb_ld(&bar[XB_TMO])) break; if (sp > XB_SPIN_CAP) { atomicAdd(&bar[XB_TMO], 1u); break; } }
    }
    nloc = mine > 0u ? mine : 1u; nx = cnt > 0u ? cnt : 1u;
}
__device__ __forceinline__ void xcd_barrier(const XcdBarrier& b, const bool leader) {
    asm volatile("s_waitcnt vmcnt(0)" ::: "memory");
    __syncthreads();
    if (leader) {
        unsigned* bar = b.bar;
        unsigned bx = xb_xcc_id(); asm volatile("" : "+s"(bx));
        __builtin_amdgcn_s_waitcnt(0);
        unsigned nloc = b.st[0], nx = b.st[1];
        if (nloc == 0u) { xcd_barrier_complete(bar, bx, nloc, nx); b.st[0] = nloc; b.st[1] = nx; }
        const unsigned old = xb_add(&bar[XB_XSUB(bx)], 1u);
        const unsigned gen = old / nloc;
        if (old + 1u == (gen + 1u) * nloc) {
            __builtin_amdgcn_fence(__ATOMIC_RELEASE, "agent");
            asm volatile("s_waitcnt vmcnt(0)" ::: "memory");
            const unsigned og = xb_add(&bar[XB_TOP], 1u);
            const unsigned tg = og / nx;
            if (og + 1u == (tg + 1u) * nx) xb_add(&bar[XB_TOPGEN], 1u);
            else XB_SPIN(xb_ld(&bar[XB_TOPGEN]) == tg, bar);
            __builtin_amdgcn_fence(__ATOMIC_ACQUIRE, "agent");
            xb_add(&bar[XB_XGEN(bx)], 1u);
            asm volatile("s_waitcnt vmcnt(0)" ::: "memory");
        } else {
            XB_SPIN(xb_ld(&bar[XB_XGEN(bx)]) == gen, bar);
            __builtin_amdgcn_fence(__ATOMIC_ACQUIRE, "agent");
            asm volatile("s_waitcnt vmcnt(0)" ::: "memory");
        }
    }
    __syncthreads();
}

constexpr int LDS_BYTES = 151552;
constexpr int LDS_MISC = 147456;
constexpr int NT = 512;
constexpr int LDS_GOFF = 131072;

__device__ __forceinline__ int opaque_tid(const int wv) { int t = wv * 64 + (int)__builtin_amdgcn_mbcnt_hi(~0u, __builtin_amdgcn_mbcnt_lo(~0u, 0u)); asm volatile("" : "+v"(t)); return t; }
namespace pg8 {
typedef short bf16x8 __attribute__((ext_vector_type(8)));
constexpr int BM = 256, BK = 64, HALF = 128, HTB = HALF * BK * 2, STAGE_BYTES = 8 * HTB, NXCD = 8, WGM = 8;
__device__ __forceinline__ int lds_byte(int r, int c) { const int st = (r >> 4) * 2 + (c >> 5), rr = r & 15, cc = c & 31, ob = rr * 64 + cc * 2; return st * 1024 + (ob ^ (((ob >> 9) & 1) << 5)); }
__device__ __forceinline__ void stage_rc(int b, int& R, int& C) { const int st = b / 1024, sb = b % 1024, swz = sb ^ (((sb >> 9) & 1) << 5); R = (st >> 1) * 16 + swz / 64; C = (st & 1) * 32 + (swz % 64) / 2; }
__device__ __forceinline__ int perm32(int rho) { const int n = rho >> 4, i = rho & 15; return 8 * (i >> 2) + 4 * n + (i & 3); }

struct Unit { const char* A; const char* B; int pm, pn, x0, x1; };

template <class Epi, class Sched, bool GATHER = false, int NBH = 2>
__device__ __forceinline__ void gemm_phase(LAS unsigned char* lds, const int wv, const int lda, const int ldb, const int K, const Sched& S, Epi& E) {
    const int tid = opaque_tid(wv);
    const int wid = __builtin_amdgcn_readfirstlane(tid >> 6), lane = tid & 63, wr = wid >> 2, wc = wid & 3, fr = lane & 15, fq = lane >> 4;
    const int nt = K / BK;
    int sR[2], sC2[2]; unsigned voffB[2];
#pragma unroll
    for (int i = 0; i < 2; ++i) { int R, C; stage_rc(tid * 16 + i * 8192, R, C); const int Rb = Epi::PERM ? ((R & ~31) + perm32(R & 31)) : R;
        sR[i] = R; sC2[i] = C * 2; voffB[i] = (unsigned)(Rb * ldb + C) * 2u; }
    const size_t kstep = (size_t)(BK * 2);
    const unsigned hstepA = (unsigned)HALF * (unsigned)lda * 2u;
    const size_t hstepB = (size_t)HALF * ldb * 2;
    const unsigned ldsw = (unsigned)wid * 1024u;
    const int aoff = lds_byte(wr * 64 + fr, fq * 8), boff = lds_byte(wc * 32 + fr, fq * 8);
#define PG8_SA(b, h) (((b) * 2 + (h)) * HTB)
#define PG8_SB(b, h) ((4 + (b) * 2 + (h)) * HTB)
#define PG8_STAGE2(bufoff, gbase, v0, v1) do { \
        __builtin_amdgcn_global_load_lds((const unsigned*)((const char*)(gbase) + (v0)), (LAS unsigned*)(lds + (bufoff) + ldsw), 16, 0, 0); \
        __builtin_amdgcn_global_load_lds((const unsigned*)((const char*)(gbase) + (v1)), (LAS unsigned*)(lds + (bufoff) + ldsw + 8192), 16, 0, 0); } while (0)
#define PG8_STAGEB(bufoff, gbase) PG8_STAGE2(bufoff, gbase, voffB[0], voffB[1])
#define PG8_LDA(dst, b, h) do { _Pragma("unroll") for (int m = 0; m < 4; ++m) _Pragma("unroll") for (int k = 0; k < 2; ++k) dst[m][k] = *(const LAS bf16x8*)(lds + PG8_SA(b, h) + aoff + m * 2048 + k * 1024); } while (0)
#define PG8_LDB(dst, b, h) do { _Pragma("unroll") for (int n = 0; n < 2; ++n) _Pragma("unroll") for (int k = 0; k < 2; ++k) dst[n][k] = *(const LAS bf16x8*)(lds + PG8_SB(b, h) + boff + n * 2048 + k * 1024); } while (0)
#define PG8_MMA(ai, bj, At, Bt) do { __builtin_amdgcn_s_setprio(1); _Pragma("unroll") for (int m = 0; m < 4; ++m) _Pragma("unroll") for (int n = 0; n < 2; ++n) _Pragma("unroll") for (int k = 0; k < 2; ++k) \
        acc[ai][bj][m][n] = __builtin_amdgcn_mfma_f32_16x16x32_bf16(Bt[n][k], At[m][k], acc[ai][bj][m][n], 0, 0, 0); __builtin_amdgcn_s_setprio(0); } while (0)
#define PG8_WAIT_V(n) asm volatile("s_waitcnt vmcnt(" #n ")" ::: "memory")
#define PG8_WAIT_L(n) asm volatile("s_waitcnt lgkmcnt(" #n ")" ::: "memory")
#define PG8_BAR __builtin_amdgcn_s_barrier()
#define PG8_SCHED __builtin_amdgcn_sched_barrier(0)
    Unit cur, nxt; int ui = 0;
    if (!S.next(0, cur)) return;
    f32x4 acc[2][NBH][4][2];
#pragma unroll
    for (int a = 0; a < 2; ++a)
#pragma unroll
        for (int b = 0; b < NBH; ++b)
#pragma unroll
            for (int m = 0; m < 4; ++m)
#pragma unroll
                for (int n = 0; n < 2; ++n) acc[a][b][m][n] = (f32x4){0.f, 0.f, 0.f, 0.f};
    bf16x8 At[4][2], B0[2][2], B1[2][2];
    unsigned voffA[2]; unsigned ga[2][2];
#pragma unroll
    for (int i = 0; i < 2; ++i) voffA[i] = (unsigned)(sR[i] * lda) * 2u + (unsigned)sC2[i];
    if constexpr (GATHER) {
#pragma unroll
        for (int i = 0; i < 2; ++i) { ga[0][i] = S.row_off(cur, sR[i]) + (unsigned)sC2[i]; ga[1][i] = S.row_off(cur, HALF + sR[i]) + (unsigned)sC2[i]; }
    }
#define PG8_STAGEA(bufoff, gbase, h, nx) do { if constexpr (GATHER) { PG8_STAGE2(bufoff, gbase, ga[h][0], ga[h][1]); } \
        else { PG8_STAGE2(bufoff, (gbase) + (h) * (size_t)hstepA, voffA[0], voffA[1]); } } while (0)
    const char* cA = cur.A; const char* cB = cur.B;
    if constexpr (Epi::HAS_PRE) { const int t3 = opaque_tid(wv) & 63; E.pre(cur, wr, wc, t3 & 15, t3 >> 4); }
    if constexpr (NBH == 2) {
        PG8_STAGEB(PG8_SB(0, 0), cB); PG8_STAGEB(PG8_SB(0, 1), cB + hstepB); PG8_STAGEA(PG8_SA(0, 0), cA, 0, false); PG8_STAGEA(PG8_SA(0, 1), cA, 1, false);
        if (wr == 1) PG8_BAR;
        PG8_WAIT_V(2); PG8_BAR;
        PG8_STAGEB(PG8_SB(1, 0), cB + kstep); PG8_STAGEA(PG8_SA(1, 0), cA + kstep, 0, false); PG8_STAGEB(PG8_SB(1, 1), cB + hstepB + kstep);
        PG8_WAIT_V(6); PG8_BAR;
    } else {
        PG8_STAGEB(PG8_SB(0, 0), cB); PG8_STAGEA(PG8_SA(0, 0), cA, 0, false); PG8_STAGEA(PG8_SA(0, 1), cA, 1, false);
        if (wr == 1) PG8_BAR;
        PG8_WAIT_V(2); PG8_BAR;
        PG8_STAGEB(PG8_SB(1, 0), cB + kstep); PG8_STAGEA(PG8_SA(1, 0), cA + kstep, 0, false);
        PG8_WAIT_V(4); PG8_BAR;
    }
#pragma unroll 1
    for (;;) {
        const bool has_next = S.next(ui + 1, nxt);
        const char* nA = has_next ? nxt.A : cA; const char* nB = has_next ? nxt.B : cB;
#pragma unroll 1
        for (int t = 0; t < nt; t += 2) {
            const bool last = (t == nt - 2);
            const char* a1 = cA + (size_t)(t + 1) * kstep;
            const char* a2 = last ? nA : cA + (size_t)(t + 2) * kstep; const char* b2 = last ? nB : cB + (size_t)(t + 2) * kstep;
            const char* a3 = a2 + kstep; const char* b3 = b2 + kstep;
            if constexpr (NBH == 2) {
            PG8_LDB(B0, 0, 0); PG8_LDB(B1, 0, 1); PG8_SCHED; PG8_LDA(At, 0, 0); PG8_STAGEA(PG8_SA(1, 1), a1, 1, false);
            PG8_WAIT_V(8); PG8_WAIT_L(0); PG8_BAR; PG8_MMA(0, 0, At, B0); PG8_MMA(0, 1, At, B1); PG8_BAR; PG8_SCHED;
            PG8_LDA(At, 0, 1); PG8_STAGEB(PG8_SB(0, 0), b2); PG8_STAGEB(PG8_SB(0, 1), b2 + hstepB); PG8_STAGEA(PG8_SA(0, 0), a2, 0, last);
            PG8_WAIT_V(8); PG8_WAIT_L(0); PG8_BAR; PG8_MMA(1, 0, At, B0); PG8_MMA(1, 1, At, B1); PG8_BAR; PG8_SCHED;
            PG8_LDB(B0, 1, 0); PG8_LDB(B1, 1, 1); PG8_SCHED; PG8_LDA(At, 1, 0); PG8_STAGEA(PG8_SA(0, 1), a2, 1, last);
            PG8_WAIT_V(8); PG8_WAIT_L(0); PG8_BAR; PG8_MMA(0, 0, At, B0); PG8_MMA(0, 1, At, B1); PG8_BAR; PG8_SCHED;
            PG8_LDA(At, 1, 1); PG8_STAGEB(PG8_SB(1, 0), b3); PG8_STAGEB(PG8_SB(1, 1), b3 + hstepB); PG8_STAGEA(PG8_SA(1, 0), a3, 0, last);
            PG8_WAIT_V(8); PG8_WAIT_L(0); PG8_BAR; PG8_MMA(1, 0, At, B0); PG8_MMA(1, 1, At, B1); PG8_BAR; PG8_SCHED;
            } else {
            PG8_LDB(B0, 0, 0); PG8_SCHED; PG8_LDA(At, 0, 0); PG8_STAGEA(PG8_SA(1, 1), a1, 1, false);
            PG8_WAIT_V(6); PG8_WAIT_L(0); PG8_BAR; PG8_MMA(0, 0, At, B0); PG8_BAR; PG8_SCHED;
            PG8_LDA(At, 0, 1); PG8_STAGEB(PG8_SB(0, 0), b2); PG8_STAGEA(PG8_SA(0, 0), a2, 0, last);
            PG8_WAIT_V(6); PG8_WAIT_L(0); PG8_BAR; PG8_MMA(1, 0, At, B0); PG8_BAR; PG8_SCHED;
            PG8_LDB(B0, 1, 0); PG8_SCHED; PG8_LDA(At, 1, 0); PG8_STAGEA(PG8_SA(0, 1), a2, 1, last);
            PG8_WAIT_V(6); PG8_WAIT_L(0); PG8_BAR; PG8_MMA(0, 0, At, B0); PG8_BAR; PG8_SCHED;
            PG8_LDA(At, 1, 1); PG8_STAGEB(PG8_SB(1, 0), b3); PG8_STAGEA(PG8_SA(1, 0), a3, 0, last);
            PG8_WAIT_V(6); PG8_WAIT_L(0); PG8_BAR; PG8_MMA(1, 0, At, B0); PG8_BAR; PG8_SCHED;
            }
        }
        if (wr == 0) PG8_BAR;
        { const int t3 = opaque_tid(wv) & 63; E(acc, cur, wr, wc, t3 & 15, t3 >> 4); }
        if (!has_next) break;
#pragma unroll
        for (int a = 0; a < 2; ++a)
#pragma unroll
            for (int b = 0; b < NBH; ++b)
#pragma unroll
                for (int m = 0; m < 4; ++m)
#pragma unroll
                    for (int n = 0; n < 2; ++n) acc[a][b][m][n] = (f32x4){0.f, 0.f, 0.f, 0.f};
        cur = nxt; cA = nA; cB = nB; ++ui;
        if constexpr (Epi::HAS_PRE) { const int t3 = opaque_tid(wv) & 63; E.pre(cur, wr, wc, t3 & 15, t3 >> 4); }
        if (wr == 1) PG8_BAR;
    }
    PG8_WAIT_V(0);
    PG8_BAR;
#undef PG8_SA
#undef PG8_SB
#undef PG8_STAGE2
#undef PG8_STAGEB
#undef PG8_STAGEA
#undef PG8_LDA
#undef PG8_LDB
#undef PG8_MMA
#undef PG8_WAIT_V
#undef PG8_WAIT_L
#undef PG8_BAR
#undef PG8_SCHED
}

struct DenseOrder {
    const char* A; const char* B; size_t tstepA, tstepB; int nM, nN, nwg, G, c;
    __device__ __forceinline__ void init(const void* A_, const void* B_, int Mr, int N, int lda, int ldb, int G_, int c_) {
        A = (const char*)A_; B = (const char*)B_; tstepA = (size_t)BM * lda * 2; tstepB = (size_t)BM * ldb * 2; nM = Mr / BM; nN = N / BM; nwg = nM * nN; G = G_; c = c_; }
    __device__ __forceinline__ bool next(int i, Unit& u) const {
        const long L = (long)i * G + c; if (L >= nwg) return false;
        int wgid = (int)L; { const int q = nwg / NXCD, r = nwg % NXCD, xcd = wgid % NXCD, off = wgid / NXCD; wgid = (xcd < r ? xcd * (q + 1) : r * (q + 1) + (xcd - r) * q) + off; }
        const int nig = WGM * nN, gid = wgid / nig, fm = gid * WGM, gsz = (nM - fm) < WGM ? (nM - fm) : WGM;
        u.pm = fm + ((wgid % nig) % gsz); u.pn = (wgid % nig) / gsz; u.x0 = 0; u.x1 = 0;
        u.A = A + (size_t)u.pm * tstepA; u.B = B + (size_t)u.pn * tstepB; return true;
    }
};
}

__device__ __forceinline__ float gelu_fast(float x) { const float u2 = -2.3022081984f * (x + 0.044715f * x * x * x); return x * __builtin_amdgcn_rcpf(1.f + __builtin_amdgcn_exp2f(u2)); }
__device__ __forceinline__ float sigm_fast(float x) { return __builtin_amdgcn_rcpf(1.f + __builtin_amdgcn_exp2f(-1.4426950408889634f * x)); }
__device__ __forceinline__ u32x4 pack8(const f32x4 a, const f32x4 b) { u32x4 w; w.x = pk2(a.x, a.y); w.y = pk2(a.z, a.w); w.z = pk2(b.x, b.y); w.w = pk2(b.z, b.w); return w; }
__device__ __forceinline__ void unpack8(const u32x4 w, f32x4& a, f32x4& b) { a = (f32x4){bflo(w.x), bfhi(w.x), bflo(w.y), bfhi(w.y)}; b = (f32x4){bflo(w.z), bfhi(w.z), bflo(w.w), bfhi(w.w)}; }

typedef const f32x4 (&AccRef)[2][2][4][2];
typedef const f32x4 (&AccRef1)[2][1][4][2];
struct EpiP1 {
    static constexpr bool PERM = true;
    static constexpr bool HAS_PRE = false;
    bf16 *UG, *GU, *GV, *QB, *GATES; const float* b_gate;
    __device__ __forceinline__ void operator()(AccRef acc, const pg8::Unit& u, int wr, int wc, int fr, int fq) const {
        asm volatile("" : "+v"(fr), "+v"(fq));
        const int pn = u.pn;
        f32x4 gb0[2], gb1[2];
#pragma unroll
        for (int bj = 0; bj < 2; ++bj) { const int c = ((pn >= 8) ? (pn - 8) * 256 : 0) + bj * 128 + wc * 32 + 8 * fq; gb0[bj] = *(const f32x4*)(b_gate + c); gb1[bj] = *(const f32x4*)(b_gate + c + 4); }
#pragma unroll
        for (int ai = 0; ai < 2; ++ai)
#pragma unroll
            for (int m = 0; m < 4; ++m) {
                const size_t row = (size_t)u.pm * 256 + ai * 128 + wr * 64 + m * 16 + fr;
#pragma unroll
                for (int bj = 0; bj < 2; ++bj) {
                    const int cl = bj * 128 + wc * 32 + 8 * fq;
                    f32x4 v0 = acc[ai][bj][m][0], v1 = acc[ai][bj][m][1];
                    if (pn < 2) { const int c = pn * 256 + cl; *(u32x4*)(UG + ((size_t)(c >> 4) * NCHK + (row >> 4)) * 512 + (row & 15) * 16 + (c & 15)) = pack8(v0, v1); }
                    else if (pn < 6) {
#pragma unroll
                        for (int j = 0; j < 4; ++j) { v0[j] = gelu_fast(v0[j]); v1[j] = gelu_fast(v1[j]); }
                        bf16* dst = (pn < 4) ? (GU + row * 512 + (pn - 2) * 256 + cl) : (GV + row * 512 + (pn - 4) * 256 + cl);
                        *(u32x4*)dst = pack8(v0, v1);
                    }
                    else if (pn < 8) { *(u32x4*)(QB + row * 512 + (pn - 6) * 256 + cl) = pack8(v0, v1); }
                    else {
                        const int c = (pn - 8) * 256 + cl;
#pragma unroll
                        for (int j = 0; j < 4; ++j) { v0[j] = sigm_fast(v0[j] + gb0[bj][j]); v1[j] = sigm_fast(v1[j] + gb1[bj][j]); }
                        *(u32x4*)(GATES + row * NGATE + c) = pack8(v0, v1);
                    }
                }
            }
    }
};
struct EpiKV {
    static constexpr bool PERM = true;
    static constexpr bool HAS_PRE = false;
    bf16 *KBl, *VTl;
    __device__ __forceinline__ void operator()(AccRef acc, const pg8::Unit& u, int wr, int wc, int fr, int fq) const {
        asm volatile("" : "+v"(fr), "+v"(fq));
#pragma unroll
        for (int ai = 0; ai < 2; ++ai)
#pragma unroll
            for (int m = 0; m < 4; ++m) {
                const int row = u.pm * 256 + ai * 128 + wr * 64 + m * 16 + fr, b = u.x0 * 2 + (row >> 8), mm = row & 255;
#pragma unroll
                for (int bj = 0; bj < 2; ++bj) {
                    const int c = u.pn * 256 + bj * 128 + wc * 32 + 8 * fq;
                    const f32x4 v0 = acc[ai][bj][m][0], v1 = acc[ai][bj][m][1];
                    if (c < 512) { const int h = c >> 7, d = c & 127; *(u32x4*)(KBl + (((size_t)b * 4 + h) * 256 + mm) * 128 + d) = pack8(v0, v1); }
                    else { const int cc = c - 512, h = cc >> 7, d = cc & 127; bf16* p = VTl + (((size_t)b * 4 + h) * 128 + d) * 256 + mm;
#pragma unroll
                        for (int j = 0; j < 4; ++j) { p[(size_t)j * 256] = (bf16)f2bf(v0[j]); p[(size_t)(4 + j) * 256] = (bf16)f2bf(v1[j]); } }
                }
            }
    }
};
struct EpiGLU {
    static constexpr bool PERM = true;
    static constexpr bool HAS_PRE = false;
    const bf16* YS; bf16* YSSM; const float* b_glu;
    __device__ __forceinline__ void operator()(AccRef1 acc, const pg8::Unit& u, int wr, int wc, int fr, int fq) const {
        asm volatile("" : "+v"(fr), "+v"(fq));
        const int c0 = u.pn * 128 + wc * 32 + 8 * fq;
        const f32x4 b0 = *(const f32x4*)(b_glu + c0), b1 = *(const f32x4*)(b_glu + c0 + 4);
        u32x4 yv[2][4];
#pragma unroll
        for (int ai = 0; ai < 2; ++ai)
#pragma unroll
            for (int m = 0; m < 4; ++m) yv[ai][m] = *(const u32x4*)(YS + ((size_t)u.pm * 256 + ai * 128 + wr * 64 + m * 16 + fr) * 512 + c0);
        __builtin_amdgcn_sched_barrier(0);
#pragma unroll
        for (int ai = 0; ai < 2; ++ai)
#pragma unroll
            for (int m = 0; m < 4; ++m) {
                f32x4 v0 = acc[ai][0][m][0], v1 = acc[ai][0][m][1], y0, y1; unpack8(yv[ai][m], y0, y1);
#pragma unroll
                for (int j = 0; j < 4; ++j) { v0[j] = y0[j] * sigm_fast(v0[j] + b0[j]); v1[j] = y1[j] * sigm_fast(v1[j] + b1[j]); }
                *(u32x4*)(YSSM + ((size_t)u.pm * 256 + ai * 128 + wr * 64 + m * 16 + fr) * 512 + c0) = pack8(v0, v1);
            }
    }
};
struct GluOrder {
    const char* A; const char* B; int G, c;
    __device__ __forceinline__ bool next(int i, pg8::Unit& u) const {
        const int t = i * G + c; if (t >= 256) return false;
        const int x = t & 7, k = t >> 3; u.pm = x * 8 + (k >> 2); u.pn = k & 3; u.x0 = 0; u.x1 = 0;
        u.A = A + (size_t)u.pm * 256 * 512 * 2; u.B = B + (size_t)u.pn * 128 * 512 * 2; return true;
    }
};
struct MergeOrder {
    const char* Y0; const char* Y1; const char* Y2; const char* W; int G, c;
    __device__ __forceinline__ bool next(int i, pg8::Unit& u) const {
        const int ts = i / 3, bi = i - ts * 3, t = ts * G + c; if (t >= 512) return false;
        const int x = t & 7, k = t >> 3; u.pm = x * 8 + (k >> 3); u.pn = k & 7; u.x1 = bi; u.x0 = (bi == 2) ? 0 : bi + 1;
        u.A = ((u.x0 == 0) ? Y0 : (u.x0 == 1) ? Y1 : Y2) + (size_t)u.pm * 256 * 512 * 2; u.B = W + ((size_t)u.x0 * 1024 + (size_t)u.pn * 128) * 512 * 2; return true;
    }
};
struct EpiMergeF {
    static constexpr bool PERM = true;
    static constexpr bool HAS_PRE = true;
    const bf16* GATES; bf16* MERGED;
    f32x4 tot[2][4][2];
    u32x4 gv[2][4];
    __device__ __forceinline__ void pre(const pg8::Unit& u, int wr, int wc, int fr, int fq) {
        const int c = u.pn * 128 + wc * 32 + 8 * fq;
#pragma unroll
        for (int ai = 0; ai < 2; ++ai)
#pragma unroll
            for (int m = 0; m < 4; ++m) gv[ai][m] = *(const u32x4*)(GATES + ((size_t)u.pm * 256 + ai * 128 + wr * 64 + m * 16 + fr) * NGATE + u.x0 * D + c);
    }
    __device__ __forceinline__ void operator()(AccRef1 acc, const pg8::Unit& u, int wr, int wc, int fr, int fq) {
        asm volatile("" : "+v"(fr), "+v"(fq));
        const int c = u.pn * 128 + wc * 32 + 8 * fq, bi = u.x1;
#pragma unroll
        for (int ai = 0; ai < 2; ++ai)
#pragma unroll
            for (int m = 0; m < 4; ++m) {
                f32x4 g0, g1; unpack8(gv[ai][m], g0, g1);
                f32x4 v0 = acc[ai][0][m][0] * g0, v1 = acc[ai][0][m][1] * g1;
                if (bi != 0) { v0 = v0 + tot[ai][m][0]; v1 = v1 + tot[ai][m][1]; }
                if (bi == 2) *(u32x4*)(MERGED + ((size_t)u.pm * 256 + ai * 128 + wr * 64 + m * 16 + fr) * D + c) = pack8(v0, v1);
                else { tot[ai][m][0] = v0; tot[ai][m][1] = v1; }
            }
    }
};
struct EpiOut {
    static constexpr bool PERM = false;
    static constexpr bool HAS_PRE = false;
    const bf16* XB; bf16* Z1;
    __device__ __forceinline__ void operator()(AccRef acc, const pg8::Unit& u, int wr, int wc, int fr, int fq) const {
        asm volatile("" : "+v"(fr), "+v"(fq));
        const int c0 = u.pn * 256 + wc * 32 + 4 * fq;
#pragma unroll
        for (int ai = 0; ai < 2; ++ai)
#pragma unroll
            for (int mh = 0; mh < 2; ++mh) {
                u32x2 xv[2][2][2];
#pragma unroll
                for (int mm = 0; mm < 2; ++mm)
#pragma unroll
                    for (int bj = 0; bj < 2; ++bj)
#pragma unroll
                        for (int n = 0; n < 2; ++n) xv[mm][bj][n] = *(const u32x2*)(XB + ((size_t)u.pm * 256 + ai * 128 + wr * 64 + (mh * 2 + mm) * 16 + fr) * D + c0 + bj * 128 + 16 * n);
                __builtin_amdgcn_sched_barrier(0);
#pragma unroll
                for (int mm = 0; mm < 2; ++mm)
#pragma unroll
                    for (int bj = 0; bj < 2; ++bj)
#pragma unroll
                        for (int n = 0; n < 2; ++n) { const int m = mh * 2 + mm;
                            const f32x4 z = (f32x4){bflo(xv[mm][bj][n].x), bfhi(xv[mm][bj][n].x), bflo(xv[mm][bj][n].y), bfhi(xv[mm][bj][n].y)} * ALPHA + acc[ai][bj][m][n];
                            u32x2 zw; zw.x = pk2(z.x, z.y); zw.y = pk2(z.z, z.w);
                            *(u32x2*)(Z1 + ((size_t)u.pm * 256 + ai * 128 + wr * 64 + m * 16 + fr) * D + c0 + bj * 128 + 16 * n) = zw; }
            }
    }
};
struct S5Order { const char* A; const char* B; size_t bstep; int G, c;
    __device__ __forceinline__ bool next(int i, pg8::Unit& u) const { const int L = i * G + c; if (L >= 128) return false;
        u.x0 = (L & 7) * 4 + (L >> 5); u.pm = (L >> 3) & 3; u.pn = 0; u.x1 = 0;        u.A = A + ((size_t)u.x0 * NCHK + (size_t)u.pm * 256) * 1024; u.B = B + (size_t)u.x0 * bstep; return true; } };
struct EpiS5St {
    static constexpr bool PERM = false;
    static constexpr bool HAS_PRE = false;
    float* SST;
    __device__ __forceinline__ void operator()(AccRef acc, const pg8::Unit& u, int wr, int wc, int fr, int fq) const {
        asm volatile("" : "+v"(fr), "+v"(fq));
#pragma unroll
        for (int ai = 0; ai < 2; ++ai)
#pragma unroll
            for (int m = 0; m < 4; ++m) {
                const size_t chunk = (size_t)u.pm * 256 + ai * 128 + wr * 64 + m * 16 + fr;
                float* rowp = SST + ((size_t)u.x0 * NCHK + chunk) * 256;
#pragma unroll
                for (int bj = 0; bj < 2; ++bj)
#pragma unroll
                    for (int n = 0; n < 2; ++n) *(f32x4*)(rowp + bj * 128 + wc * 32 + 16 * n + 4 * fq) = acc[ai][bj][m][n];
            }
    }
};
struct EpiS5Out {
    static constexpr bool PERM = true;
    static constexpr bool HAS_PRE = false;
    bf16* YS;
    __device__ __forceinline__ void operator()(AccRef acc, const pg8::Unit& u, int wr, int wc, int fr, int fq) const {
        asm volatile("" : "+v"(fr), "+v"(fq));
#pragma unroll
        for (int ai = 0; ai < 2; ++ai)
#pragma unroll
            for (int m = 0; m < 4; ++m) {
                const size_t chunk = (size_t)u.pm * 256 + ai * 128 + wr * 64 + m * 16 + fr;
#pragma unroll
                for (int bj = 0; bj < 2; ++bj) {
                    const int n0 = bj * 128 + wc * 32 + 8 * fq, s = n0 >> 4, h0 = n0 & 15;
                    f32x4 v0 = acc[ai][bj][m][0], v1 = acc[ai][bj][m][1];
#pragma unroll
                    for (int j = 0; j < 4; ++j) { v0[j] = gelu_fast(v0[j]); v1[j] = gelu_fast(v1[j]); }
                    *(u32x4*)(YS + (chunk * 16 + s) * 512 + u.x0 * 16 + h0) = pack8(v0, v1);
                }
            }
    }
};
struct MoeTab { int tb[33]; int sb[33]; int cn[32]; };
__device__ __forceinline__ int moe_ntile_x(const LAS MoeTab* T, int x, int NX) {
    int n = 0;
#pragma unroll 1
    for (int e = x; e < NEXP; e += NX) n += __builtin_amdgcn_readfirstlane(T->tb[e + 1]) - __builtin_amdgcn_readfirstlane(T->tb[e]);
    return n;
}
__device__ __forceinline__ void moe_local_tile(const LAS MoeTab* T, int x, int NX, int lt, int& e_out, int& pm_out) {
    int e = x;
#pragma unroll 1
    for (; e + NX < NEXP; e += NX) { const int n = __builtin_amdgcn_readfirstlane(T->tb[e + 1]) - __builtin_amdgcn_readfirstlane(T->tb[e]); if (lt < n) break; lt -= n; }
    e_out = e; pm_out = lt;
}
struct MoeOrderGU {
    const char* X1Bp; const char* WGU; const int* LIST; int e, pm, cnt, pn;
    __device__ __forceinline__ bool next(int i, pg8::Unit& u) const {
        if (i >= 1) return false;
        u.pm = pm; u.pn = pn; u.x0 = e; u.x1 = cnt;
        u.A = X1Bp; u.B = WGU + ((size_t)e * 512 + (size_t)pn * 256) * (D * 2); return true;
    }
    __device__ __forceinline__ unsigned row_off(const pg8::Unit& u, int r) const {
        const int rr = u.pm * 256 + r; const int tok = (rr < u.x1) ? (LIST[(size_t)u.x0 * LCAP + rr] >> 1) : 0;
        return (unsigned)tok * (unsigned)(D * 2);
    }
};
struct EpiMoeGU {
    static constexpr bool PERM = true;
    static constexpr bool HAS_PRE = false;
    const LAS MoeTab* T; const int* LIST; const float* TOKW; bf16* HB;
    float w[2][4];
    __device__ __forceinline__ void init(int e, int pm, int cnt, int tid) {
        const int wr = tid >> 8, fr = tid & 15; int pr[2][4];
#pragma unroll
        for (int ai = 0; ai < 2; ++ai)
#pragma unroll
            for (int m = 0; m < 4; ++m) { const int rr = pm * 256 + ai * 128 + wr * 64 + m * 16 + fr; pr[ai][m] = (rr < cnt) ? LIST[(size_t)e * LCAP + rr] : 0; }
#pragma unroll
        for (int ai = 0; ai < 2; ++ai)
#pragma unroll
            for (int m = 0; m < 4; ++m) w[ai][m] = TOKW[pr[ai][m]];
    }
    __device__ __forceinline__ void operator()(AccRef acc, const pg8::Unit& u, int wr, int wc, int fr, int fq) {
        asm volatile("" : "+v"(fr), "+v"(fq));
        const int e = u.x0, cnt = u.x1, sb = __builtin_amdgcn_readfirstlane(T->sb[e]);
#pragma unroll
        for (int ai = 0; ai < 2; ++ai)
#pragma unroll
            for (int m = 0; m < 4; ++m) {
                const int rr = u.pm * 256 + ai * 128 + wr * 64 + m * 16 + fr;
                if (rr < cnt) {
                    const int f = u.pn * 128 + wc * 32 + 8 * fq;
                    f32x4 g0 = acc[ai][0][m][0], g1 = acc[ai][0][m][1]; const f32x4 u0 = acc[ai][1][m][0], u1 = acc[ai][1][m][1];
#pragma unroll
                    for (int j = 0; j < 4; ++j) { g0[j] = g0[j] * sigm_fast(g0[j]) * u0[j] * w[ai][m]; g1[j] = g1[j] * sigm_fast(g1[j]) * u1[j] * w[ai][m]; }
                    *(u32x4*)(HB + ((size_t)sb + rr) * DEXP + f) = pack8(g0, g1);
                }
            }
    }
};
struct MoeOrderD {
    const LAS MoeTab* T; const char* HBp; const char* WD; int x, NX, d0, ds, d1;
    __device__ __forceinline__ bool next(int i, pg8::Unit& u) const {
        const int du = d0 + i * ds; if (du >= d1) return false;
        int e, pm; moe_local_tile(T, x, NX, du >> 2, e, pm);
        u.pm = pm; u.pn = du & 3; u.x0 = e; u.x1 = __builtin_amdgcn_readfirstlane(T->cn[e]);
        u.A = HBp + ((size_t)__builtin_amdgcn_readfirstlane(T->sb[e]) + (size_t)pm * 256) * (DEXP * 2); u.B = WD + ((size_t)e * D + (size_t)u.pn * 256) * (DEXP * 2); return true;
    }
};
struct EpiMoeD {
    static constexpr bool PERM = true;
    static constexpr bool HAS_PRE = true;
    const int* LIST; bf16* O2;
    int pr[2][4];
    __device__ __forceinline__ void pre(const pg8::Unit& u, int wr, int wc, int fr, int fq) {
#pragma unroll
        for (int ai = 0; ai < 2; ++ai)
#pragma unroll
            for (int m = 0; m < 4; ++m) { const int rr = u.pm * 256 + ai * 128 + wr * 64 + m * 16 + fr; pr[ai][m] = (rr < u.x1) ? LIST[(size_t)u.x0 * LCAP + rr] : 0; }
    }
    __device__ __forceinline__ void operator()(AccRef acc, const pg8::Unit& u, int wr, int wc, int fr, int fq) {
        asm volatile("" : "+v"(fr), "+v"(fq));
        const int cnt = u.x1;
#pragma unroll
        for (int ai = 0; ai < 2; ++ai)
#pragma unroll
            for (int m = 0; m < 4; ++m) {
                const int rr = u.pm * 256 + ai * 128 + wr * 64 + m * 16 + fr;
                if (rr < cnt) {
#pragma unroll
                    for (int bj = 0; bj < 2; ++bj) {
                        const int c = u.pn * 256 + bj * 128 + wc * 32 + 8 * fq;
                        *(u32x4*)(O2 + (size_t)pr[ai][m] * D + c) = pack8(acc[ai][bj][m][0], acc[ai][bj][m][1]);
                    }
                }
            }
    }
};

typedef __attribute__((address_space(4))) const unsigned char* kaptr_t;
__device__ __forceinline__ kaptr_t ka_base() { kaptr_t p = (kaptr_t)__builtin_amdgcn_kernarg_segment_ptr(); asm volatile("" : "+s"(p)); return p; }
#define KIN(k) (*(const float* const __attribute__((address_space(4)))*)(ka + 8 * (k)))

typedef float f32x16 __attribute__((ext_vector_type(16)));
typedef short s16x8 __attribute__((ext_vector_type(8)));
constexpr int AT_KSTR = 272, AT_VSTR = 520, AT_VOFF = 256 * AT_KSTR;
__device__ __forceinline__ void attn_phase(LAS unsigned char* lds, const int wv, const bf16* QB, const bf16* KBl, const bf16* VTl, bf16* YMEM, const int G, const int bid) {
    const int tid = opaque_tid(wv), lane = tid & 63, r = lane & 31, hh = lane >> 5;
    for (int u = bid; u < 256; u += G) {
        const int panel = (u & 7) * 8 + (u >> 5), hd = (u >> 3) & 3, b = panel >> 5, tile = panel & 31;
        const bf16* kg = KBl + ((size_t)b * 4 + hd) * 256 * 128; const bf16* vg = VTl + ((size_t)b * 4 + hd) * 128 * 256;
        const size_t tok = (size_t)b * SEQ + (size_t)tile * 256 + wv * 32 + r;
        s16x8 qf[8];
#pragma unroll
        for (int ks = 0; ks < 8; ++ks) qf[ks] = *(const s16x8*)(QB + tok * 512 + hd * 128 + 16 * ks + 8 * hh);
        __syncthreads();
        {
            u32x4 kw[8], vw[8];
            const int rot = (u >> 3) * 128;
#pragma unroll
            for (int k = 0; k < 8; ++k) { const int i = (tid + k * NT + rot) & 4095; kw[k] = *(const u32x4*)(kg + (size_t)i * 8); vw[k] = *(const u32x4*)(vg + (size_t)i * 8); }
#pragma unroll
            for (int k = 0; k < 8; ++k) { const int i = (tid + k * NT + rot) & 4095; *(LAS u32x4*)(lds + (i >> 4) * AT_KSTR + (i & 15) * 16) = kw[k]; }
#pragma unroll
            for (int k = 0; k < 8; ++k) { const int i = (tid + k * NT + rot) & 4095; LAS u32x2* d = (LAS u32x2*)(lds + AT_VOFF + (i >> 5) * AT_VSTR + (i & 31) * 16); d[0] = (u32x2){vw[k].x, vw[k].y}; d[1] = (u32x2){vw[k].z, vw[k].w}; }
        }
        __syncthreads();
        f32x16 acc[8];
#pragma unroll
        for (int mt = 0; mt < 8; ++mt)
#pragma unroll
            for (int i = 0; i < 16; ++i) acc[mt][i] = 0.f;
#pragma unroll
        for (int ks = 0; ks < 8; ++ks) {
            s16x8 a[8];
#pragma unroll
            for (int mt = 0; mt < 8; ++mt) a[mt] = *(const LAS s16x8*)(lds + (32 * mt + r) * AT_KSTR + (16 * ks + 8 * hh) * 2);
#pragma unroll
            for (int mt = 0; mt < 8; ++mt) acc[mt] = __builtin_amdgcn_mfma_f32_32x32x16_bf16(a[mt], qf[ks], acc[mt], 0, 0, 0);
        }
        float mx = -3.0e38f;
#pragma unroll
        for (int mt = 0; mt < 8; ++mt)
#pragma unroll
            for (int i = 0; i < 16; ++i) mx = fmaxf(mx, acc[mt][i]);
        mx = fmaxf(mx, lane_xor(mx, lane, 32));
        const float C2 = 0.08838834764831845f * 1.4426950408889634f;
        float sum = 0.f;
#pragma unroll
        for (int mt = 0; mt < 8; ++mt)
#pragma unroll
            for (int i = 0; i < 16; ++i) { const float p = __builtin_amdgcn_exp2f((acc[mt][i] - mx) * C2); acc[mt][i] = p; sum += p; }
        sum += lane_xor(sum, lane, 32);
        const float inv = 1.f / sum;
        __syncthreads();
        f32x16 o[4];
#pragma unroll
        for (int dt = 0; dt < 4; ++dt)
#pragma unroll
            for (int i = 0; i < 16; ++i) o[dt][i] = 0.f;
#pragma unroll
        for (int mt = 0; mt < 8; ++mt)
#pragma unroll
            for (int s = 0; s < 2; ++s) {
                u32x4 pw; pw.x = pk2(acc[mt][8 * s + 0], acc[mt][8 * s + 1]); pw.y = pk2(acc[mt][8 * s + 2], acc[mt][8 * s + 3]);
                pw.z = pk2(acc[mt][8 * s + 4], acc[mt][8 * s + 5]); pw.w = pk2(acc[mt][8 * s + 6], acc[mt][8 * s + 7]);
                const s16x8 pb = __builtin_bit_cast(s16x8, pw);
#pragma unroll
                for (int dt = 0; dt < 4; ++dt) {
                    const LAS unsigned char* base = lds + AT_VOFF + (32 * dt + r) * AT_VSTR + (32 * mt + 16 * s + 4 * hh) * 2;
                    const u32x2 lo = *(const LAS u32x2*)base, hi = *(const LAS u32x2*)(base + 16);
                    const u32x4 aw = (u32x4){lo.x, lo.y, hi.x, hi.y};
                    o[dt] = __builtin_amdgcn_mfma_f32_32x32x16_bf16(__builtin_bit_cast(s16x8, aw), pb, o[dt], 0, 0, 0);
                }
            }
        LAS unsigned char* ob = lds + wv * (32 * 264);
#pragma unroll
        for (int dt = 0; dt < 4; ++dt)
#pragma unroll
            for (int g4 = 0; g4 < 4; ++g4) {
                u32x2 w; w.x = pk2(o[dt][4 * g4] * inv, o[dt][4 * g4 + 1] * inv); w.y = pk2(o[dt][4 * g4 + 2] * inv, o[dt][4 * g4 + 3] * inv);
                *(LAS u32x2*)(ob + r * 264 + (32 * dt + 8 * g4 + 4 * hh) * 2) = w;
            }
        asm volatile("s_waitcnt lgkmcnt(0)" ::: "memory");
        const size_t tok0 = (size_t)b * SEQ + (size_t)tile * 256 + wv * 32;
#pragma unroll
        for (int k = 0; k < 8; ++k) {
            const int p = lane + 64 * k, t = p >> 4, c16 = p & 15;
            const u32x2 lo = *(const LAS u32x2*)(ob + t * 264 + c16 * 16), hi = *(const LAS u32x2*)(ob + t * 264 + c16 * 16 + 8);
            *(u32x4*)(YMEM + (tok0 + t) * 512 + hd * 128 + c16 * 8) = (u32x4){lo.x, lo.y, hi.x, hi.y};
        }
    }
    __syncthreads();
}

constexpr int GM_STR = 272;
__device__ __forceinline__ void gmlp_phase(LAS unsigned char* lds, const int wv, const bf16* GU, const bf16* GV, const bf16* WSP, const float* b_sp, const float* gln_g, const float* gln_b,
                                           bf16* YGMLP, const int G, const int bid) {
    const int tid = opaque_tid(wv), lane = tid & 63, r = lane & 31, hh = lane >> 5;
    for (int u0 = (bid + G / 2) % G; u0 < 128; u0 += G) {
        const int u = (G == 256) ? ((u0 & 7) * 16 + (u0 >> 3)) : u0;
        const size_t t0 = (size_t)u * CHUNK;
        const int g = wv;
        const unsigned woff = (unsigned)(r * CHUNK + 8 * hh), uoff = (unsigned)((lane >> 3) * 512 + (lane & 7) * 8);
        __syncthreads();
        s16x8 bw1[8][2];
#pragma unroll
        for (int ks = 0; ks < 8; ++ks)
#pragma unroll
            for (int n2 = 0; n2 < 2; ++n2) bw1[ks][n2] = *(const s16x8*)(WSP + (size_t)(g * CHUNK + 32 * n2) * CHUNK + 16 * ks + woff);
        float gam[8], bet[8];
#pragma unroll
        for (int e = 0; e < 8; ++e) { gam[e] = gln_g[lane + 64 * e]; bet[e] = gln_b[lane + 64 * e]; }
        for (int jb = 0; jb < 4; ++jb) {
            const int j0 = wv * 16 + jb * 4;
            float v[4][8]; float s[4], q[4];
#pragma unroll
            for (int k = 0; k < 4; ++k)
#pragma unroll
                for (int e = 0; e < 8; ++e) v[k][e] = bf2f(GV[(t0 + j0 + k) * 512 + lane + 64 * e]);
#pragma unroll
            for (int k = 0; k < 4; ++k) { s[k] = 0.f;
#pragma unroll
                for (int e = 0; e < 8; ++e) s[k] += v[k][e]; }
#pragma unroll
            for (int k = 0; k < 4; ++k) s[k] = wave_sum(s[k], lane) * (1.f / 512.f);
#pragma unroll
            for (int k = 0; k < 4; ++k) { q[k] = 0.f;
#pragma unroll
                for (int e = 0; e < 8; ++e) { v[k][e] -= s[k]; q[k] += v[k][e] * v[k][e]; } }
#pragma unroll
            for (int k = 0; k < 4; ++k) q[k] = rsqrtf(wave_sum(q[k], lane) * (1.f / 512.f) + LN_EPS);
#pragma unroll
            for (int k = 0; k < 4; k += 2)
#pragma unroll
                for (int e = 0; e < 8; ++e)
                    *(LAS unsigned*)(lds + (lane + 64 * e) * GM_STR + (j0 + k) * 2) = pk2(v[k][e] * q[k] * gam[e] + bet[e], v[k + 1][e] * q[k + 1] * gam[e] + bet[e]);
        }
        __syncthreads();
        s16x8 bw2[8][2];
#pragma unroll
        for (int ks = 0; ks < 8; ++ks)
#pragma unroll
            for (int n2 = 0; n2 < 2; ++n2) bw2[ks][n2] = *(const s16x8*)(WSP + (size_t)(g * CHUNK + 64 + 32 * n2) * CHUNK + 16 * ks + woff);
        f32x16 acc[2][4];
#pragma unroll
        for (int mt = 0; mt < 2; ++mt)
#pragma unroll
            for (int nt = 0; nt < 2; ++nt)
#pragma unroll
                for (int i = 0; i < 16; ++i) acc[mt][nt][i] = 0.f;
#pragma unroll
        for (int ks = 0; ks < 8; ++ks) {
            s16x8 a[2];
#pragma unroll
            for (int mt = 0; mt < 2; ++mt) a[mt] = *(const LAS s16x8*)(lds + (g * 64 + 32 * mt + r) * GM_STR + (16 * ks + 8 * hh) * 2);
#pragma unroll
            for (int mt = 0; mt < 2; ++mt)
#pragma unroll
                for (int n2 = 0; n2 < 2; ++n2) acc[mt][n2] = __builtin_amdgcn_mfma_f32_32x32x16_bf16(a[mt], bw1[ks][n2], acc[mt][n2], 0, 0, 0);
        }
        __builtin_amdgcn_sched_barrier(0);
#pragma unroll
        for (int mt = 0; mt < 2; ++mt)
#pragma unroll
            for (int nt = 2; nt < 4; ++nt)
#pragma unroll
                for (int i = 0; i < 16; ++i) acc[mt][nt][i] = 0.f;
#pragma unroll
        for (int ks = 0; ks < 8; ++ks) {
            s16x8 a[2];
#pragma unroll
            for (int mt = 0; mt < 2; ++mt) a[mt] = *(const LAS s16x8*)(lds + (g * 64 + 32 * mt + r) * GM_STR + (16 * ks + 8 * hh) * 2);
#pragma unroll
            for (int mt = 0; mt < 2; ++mt)
#pragma unroll
                for (int n2 = 0; n2 < 2; ++n2) acc[mt][2 + n2] = __builtin_amdgcn_mfma_f32_32x32x16_bf16(a[mt], bw2[ks][n2], acc[mt][2 + n2], 0, 0, 0);
        }
        LAS unsigned char* sl = lds + (g * 64) * GM_STR;
        asm volatile("s_waitcnt lgkmcnt(0)" ::: "memory");
#pragma unroll
        for (int nt = 0; nt < 4; ++nt) {
            const int i = 32 * nt + r; const float bias = b_sp[g * CHUNK + i];
#pragma unroll
            for (int mt = 0; mt < 2; ++mt)
#pragma unroll
                for (int g4 = 0; g4 < 4; ++g4) {
                    u32x2 w; w.x = pk2(acc[mt][nt][4 * g4] + bias, acc[mt][nt][4 * g4 + 1] + bias); w.y = pk2(acc[mt][nt][4 * g4 + 2] + bias, acc[mt][nt][4 * g4 + 3] + bias);
                    *(LAS u32x2*)(sl + i * 136 + (32 * mt + 8 * g4 + 4 * hh) * 2) = w;
                }
        }
        asm volatile("s_waitcnt lgkmcnt(0)" ::: "memory");
        u32x4 uu[16];
#pragma unroll
        for (int k = 0; k < 16; ++k) uu[k] = *(const u32x4*)(GU + (t0 + 8 * k) * 512 + g * 64 + uoff);
#pragma unroll
        for (int k = 0; k < 16; ++k) {
            const int p = lane + 64 * k, pos = p >> 3, c8 = p & 7;
            const u32x2 lo = *(const LAS u32x2*)(sl + pos * 136 + c8 * 16), hi = *(const LAS u32x2*)(sl + pos * 136 + c8 * 16 + 8);
            u32x4 w;
            w.x = pk2(bflo(uu[k].x) * bflo(lo.x), bfhi(uu[k].x) * bfhi(lo.x)); w.y = pk2(bflo(uu[k].y) * bflo(lo.y), bfhi(uu[k].y) * bfhi(lo.y));
            w.z = pk2(bflo(uu[k].z) * bflo(hi.x), bfhi(uu[k].z) * bfhi(hi.x)); w.w = pk2(bflo(uu[k].w) * bflo(hi.y), bfhi(uu[k].w) * bfhi(hi.y));
            *(u32x4*)(YGMLP + (t0 + 8 * k) * 512 + g * 64 + uoff) = w;
        }
    }
    __syncthreads();
}

__device__ __forceinline__ void transpose_item(const float* W, int ldw, int k0, int n0, bf16* WT, int ldt, int drow0, LAS float* scr, int lane) {
    const int kr = lane >> 3, n4 = (lane & 7) * 4;
    f32x4 v[8];
#pragma unroll
    for (int i = 0; i < 8; ++i) v[i] = *(const f32x4*)(W + (size_t)(k0 + 8 * i + kr) * ldw + n0 + n4);
#pragma unroll
    for (int i = 0; i < 8; ++i) { LAS float* d = scr + (8 * i + kr) * 33 + n4; d[0] = v[i].x; d[1] = v[i].y; d[2] = v[i].z; d[3] = v[i].w; }
    asm volatile("s_waitcnt lgkmcnt(0)" ::: "memory");
    const int c = lane & 7;
#pragma unroll
    for (int j = 0; j < 4; ++j) { const int n = (lane >> 3) + 8 * j; const LAS float* s = scr + (8 * c) * 33 + n;
        u32x4 o; o.x = pk2(s[0 * 33], s[1 * 33]); o.y = pk2(s[2 * 33], s[3 * 33]); o.z = pk2(s[4 * 33], s[5 * 33]); o.w = pk2(s[6 * 33], s[7 * 33]);
        *(u32x4*)(WT + (size_t)(drow0 + n) * ldt + k0 + 8 * c) = o; }
    asm volatile("s_waitcnt lgkmcnt(0)" ::: "memory");
}
constexpr size_t WE_CAT = 0;
constexpr size_t WE_GLU = WE_CAT + (size_t)5120 * 1024;
constexpr size_t WE_BR = WE_GLU + (size_t)512 * 512;
constexpr size_t WE_OUT = WE_BR + (size_t)3 * 1024 * 512;
constexpr size_t WE_SP = WE_OUT + (size_t)1024 * 1024;
constexpr size_t WL_GU = 0;
constexpr size_t WL_D = WL_GU + (size_t)32 * 512 * 1024;
constexpr int CV_IN = 16 * 64, CV_GATE = 16 * 96, CV_GLU = 8 * 16, CV_BR = 8 * 32, CV_OUT = 16 * 32, CV_EG = 16 * 8, CV_ED = 4 * 32;
constexpr int CV_EARLY = CV_IN + CV_GATE + CV_GLU + 3 * CV_BR + CV_OUT, CV_LATE = 32 * CV_EG * 2 + 32 * CV_ED;
__device__ __forceinline__ void convert_early_item(const kaptr_t ka, int l, bf16* WE, int it, LAS float* scr, int lane) {
    int r = it;
    if (r < CV_IN) { transpose_item(KIN(2) + (size_t)l * D * INW, INW, (r / 64) * 64, (r % 64) * 32, WE + WE_CAT, D, (r % 64) * 32, scr, lane); return; } r -= CV_IN;
    if (r < CV_GATE) { transpose_item(KIN(3) + (size_t)l * D * NGATE, NGATE, (r / 96) * 64, (r % 96) * 32, WE + WE_CAT, D, 2048 + (r % 96) * 32, scr, lane); return; } r -= CV_GATE;
    if (r < CV_GLU) { transpose_item(KIN(13) + (size_t)l * 512 * 512, 512, (r / 16) * 64, (r % 16) * 32, WE + WE_GLU, 512, (r % 16) * 32, scr, lane); return; } r -= CV_GLU;
    if (r < 3 * CV_BR) { const int b = r / CV_BR, q = r % CV_BR; transpose_item(KIN(20) + ((size_t)l * 3 + b) * 512 * D, D, (q / 32) * 64, (q % 32) * 32, WE + WE_BR + (size_t)b * 1024 * 512, 512, (q % 32) * 32, scr, lane); return; } r -= 3 * CV_BR;
    transpose_item(KIN(21) + (size_t)l * D * D, D, (r / 32) * 64, (r % 32) * 32, WE + WE_OUT, D, (r % 32) * 32, scr, lane);
}
__device__ __forceinline__ void convert_late_item(const kaptr_t ka, int l, bf16* WL, int it, LAS float* scr, int lane) {
    int r = it;
    if (r < 64 * CV_EG) { const int sel = r / (32 * CV_EG), q0 = r % (32 * CV_EG), e = q0 / CV_EG, q = q0 % CV_EG; const int n0 = (q % 8) * 32;
        transpose_item(KIN(28 + sel) + ((size_t)l * 32 + e) * D * DEXP, DEXP, (q / 8) * 64, n0, WL + WL_GU + (size_t)e * 512 * 1024, D, (n0 >> 7) * 256 + sel * 128 + (n0 & 127), scr, lane); return; } r -= 64 * CV_EG;
    { const int e = r / CV_ED, q = r % CV_ED; transpose_item(KIN(30) + ((size_t)l * 32 + e) * DEXP * D, D, (q / 32) * 64, (q % 32) * 32, WL + WL_D + (size_t)e * 1024 * 256, DEXP, (q % 32) * 32, scr, lane); }
}
__device__ __forceinline__ void convert_early_share(const kaptr_t ka, int l, bf16* WE, int it0, int step, LAS float* scr, int lane) {
    for (int it = it0; it < CV_EARLY; it += step) convert_early_item(ka, l, WE, it, scr, lane);
    const f32x4* wsp = (const f32x4*)(KIN(17) + (size_t)l * GG * CHUNK * CHUNK);
    for (int i = it0 * 64 + lane; i < GG * CHUNK * CHUNK / 4; i += step * 64) { const f32x4 v = wsp[i]; u32x2 w; w.x = pk2(v.x, v.y); w.y = pk2(v.z, v.w); ((u32x2*)(WE + WE_SP))[i] = w; }
}
#define PHASE_IDS() const int tid = opaque_tid(wv), lane = tid & 63, wave = __builtin_amdgcn_readfirstlane(tid >> 6); (void)lane; (void)wave
#define PHASE_PTRS() \
    int bid_l = bid; asm volatile("" : "+s"(bid_l)); (void)bid_l; \
    const kaptr_t ka = ka_base(); unsigned char* ws = *(unsigned char* const __attribute__((address_space(4)))*)(ka + 272); \
    unsigned* ctl = (unsigned*)(ws + WS_CTL); float* X32 = (float*)(ws + WS_X32); bf16* XB = (bf16*)(ws + WS_XB); \
    float* Z1 = (float*)(ws + WS_Z1); bf16* X1B = (bf16*)(ws + WS_X1B); \
    bf16* UG = (bf16*)(ws + WS_AEXT); bf16* GU = (bf16*)(ws + WS_GU); bf16* GV = (bf16*)(ws + WS_GV); bf16* QB = (bf16*)(ws + WS_Q); \
    bf16* GATES = (bf16*)(ws + WS_GATES); \
    bf16* YS = (bf16*)(ws + WS_YS); bf16* YSSM = (bf16*)(ws + WS_YSSM); bf16* YGMLP = (bf16*)(ws + WS_YGMLP); bf16* YMEM = (bf16*)(ws + WS_YMEM); \
    bf16* MERGED = (bf16*)(ws + WS_MERGED); bf16* T0 = (bf16*)(ws + WS_T0); bf16* T1 = (bf16*)(ws + WS_T1); \
    bf16* KB = (bf16*)(ws + WS_KB); bf16* VT = (bf16*)(ws + WS_VT); \
    bf16* HB = (bf16*)(ws + WS_HB); int* LIST = (int*)(ws + WS_LIST); float* TOKW = (float*)(ws + WS_TOKW); \
    bf16* O2 = (bf16*)(ws + WS_O2); bf16* WBL = (bf16*)(ws + WS_WBL); (void)WBL; float* S5TAB = (float*)(ws + WS_S5TAB); (void)S5TAB; \
    bf16* WKVT = (bf16*)(ws + WS_GATES); bf16* MEMB = (bf16*)(ws + WS_GATES + 8 * MiB); \
    float* SST = (float*)(ws + WS_SST); bf16* S5E = (bf16*)(ws + WS_S5E); bf16* S5BT = (bf16*)(ws + WS_S5BT); float* PTAB = (float*)(ws + WS_PTAB); float* KTAB = (float*)(ws + WS_KTAB); \
    (void)SST; (void)S5E; (void)S5BT; (void)PTAB; (void)KTAB; \
    (void)ctl; (void)X32; (void)XB; (void)Z1; (void)X1B; (void)UG; (void)GU; (void)GV; (void)QB; (void)GATES; (void)YS; (void)YSSM; (void)YGMLP; (void)YMEM; \
    (void)MERGED; (void)T0; (void)T1; (void)KB; (void)VT; (void)HB; (void)LIST; (void)TOKW; (void)O2; (void)WKVT; (void)MEMB
#define PHASE_LPTRS() \
    int l = l_iter; asm volatile("" : "+s"(l)); \
    bf16* WBE = (bf16*)(ws + ((l & 1) ? WS_WBE1 : WS_WBE0)); (void)WBE; \
    const float* b_gate = KIN(4) + (size_t)l * NGATE; \
    const float* lam_re = KIN(5) + (size_t)l * 2 * SG * SP; const float* lam_im = KIN(6) + (size_t)l * 2 * SG * SP; \
    const float* log_step = KIN(7) + (size_t)l * 2 * SG; \
    const float* sb_re = KIN(8) + (size_t)l * SG * SP * SGC; const float* sb_im = KIN(9) + (size_t)l * SG * SP * SGC; \
    const float* sc_re = KIN(10) + (size_t)l * SG * SGC * SP; const float* sc_im = KIN(11) + (size_t)l * SG * SGC * SP; \
    const float* ssm_d = KIN(12) + (size_t)l * SSMW; const float* b_glu = KIN(14) + (size_t)l * SSMW; \
    const float* gln_g = KIN(15) + (size_t)l * GW; const float* gln_b = KIN(16) + (size_t)l * GW; \
    const float* w_sp = KIN(17) + (size_t)l * GG * CHUNK * CHUNK; const float* b_sp = KIN(18) + (size_t)l * GG * CHUNK; \
    const float* ln1_g = KIN(22) + (size_t)l * D; const float* ln1_b = KIN(23) + (size_t)l * D; \
    const float* w_rg = KIN(24) + (size_t)l * D * NGRP; const float* b_rg = KIN(25) + (size_t)l * NGRP; \
    const float* w_re = KIN(26) + (size_t)l * NGRP * D * EPG; const float* b_re = KIN(27) + (size_t)l * NGRP * EPG; \
    const float* ln2_g = KIN(31) + (size_t)l * D; const float* ln2_b = KIN(32) + (size_t)l * D; \
    (void)b_gate; (void)lam_re; (void)lam_im; (void)log_step; (void)sb_re; (void)sb_im; (void)sc_re; (void)sc_im; (void)ssm_d; (void)b_glu; (void)gln_g; (void)gln_b; \
    (void)w_sp; (void)b_sp; (void)ln1_g; (void)ln1_b; (void)w_rg; (void)b_rg; (void)w_re; (void)b_re; (void)ln2_g; (void)ln2_b
struct Args { const float* in[33]; float* out; unsigned char* ws; };

__global__ void __launch_bounds__(NT, 2) fwd_kernel(Args args) {
    extern __shared__ __attribute__((aligned(16))) unsigned char lds_raw[];
    float* smf = (float*)lds_raw;
    LAS unsigned char* lds = (LAS unsigned char*)lds_raw;
    const int G = gridDim.x, bid = blockIdx.x;
    const int wv = __builtin_amdgcn_readfirstlane((int)threadIdx.x >> 6);
    if (threadIdx.x < 64) ((LAS unsigned*)(lds + LDS_MISC))[threadIdx.x] = 0u;
    __syncthreads();
    XcdBarrier bar = xcd_barrier_post((unsigned*)(args.ws + WS_CTL) + CW_BAR, (volatile LAS unsigned*)(lds + LDS_MISC));
#define GRID_BAR() do { const int t_ = opaque_tid(wv); xcd_barrier(bar, t_ == 0); } while (0)
    LAS MoeTab* mtab = (LAS MoeTab*)(lds + LDS_MISC + 256);
    const int NGW = G * 8;

    {
        PHASE_IDS(); PHASE_PTRS(); const int gw = bid * 8 + wave; LAS float* cscr = (LAS float*)(lds + wave * 16384);
        const float* x_in = KIN(0); const float* mem = KIN(1);
        const size_t n4 = (size_t)M * D / 4;
        for (size_t i0 = (size_t)bid * NT + tid; i0 < n4; i0 += (size_t)G * NT * 8) {
            f32x4 v[8];
#pragma unroll
            for (int k = 0; k < 8; ++k) { const size_t i = i0 + (size_t)k * G * NT; v[k] = (i < n4) ? ((const f32x4*)x_in)[i] : (f32x4){0.f, 0.f, 0.f, 0.f}; }
#pragma unroll
            for (int k = 0; k < 8; ++k) { const size_t i = i0 + (size_t)k * G * NT; if (i < n4) { u32x2 w; w.x = pk2(v[k].x, v[k].y); w.y = pk2(v[k].z, v[k].w); ((u32x2*)XB)[i] = w; } }
        }
        const size_t m4 = (size_t)BATCH * NMEM * D / 4;
        for (size_t i = (size_t)bid * NT + tid; i < m4; i += (size_t)G * NT) {
            const f32x4 v = ((const f32x4*)mem)[i];
            u32x2 w; w.x = pk2(v.x, v.y); w.y = pk2(v.z, v.w);
            ((u32x2*)MEMB)[i] = w;
        }
        for (int i = bid * NT + tid; i < DEPTH * 2 * SG * SP; i += G * NT) {
            const float lr = KIN(5)[i], li = KIN(6)[i], st = expf(KIN(7)[i >> 6]);
            const float mag = expf(lr * st), lbr = mag * cosf(li * st), lbi = mag * sinf(li * st);
            const float nr = lbr - 1.f, ni = lbi, den = lr * lr + li * li;
            float pr = 1.f, pi = 0.f; float* pt = PTAB + (size_t)i * 34;
#pragma unroll 1
            for (int k = 0; k <= TCH; ++k) { pt[2 * k] = pr; pt[2 * k + 1] = pi; const float t = pr * lbr - pi * lbi; pi = pr * lbi + pi * lbr; pr = t; }
            *(f32x4*)(S5TAB + (size_t)i * 8) = (f32x4){lbr, lbi, (nr * lr + ni * li) / den, (ni * lr - nr * li) / den};
            *(f32x4*)(S5TAB + (size_t)i * 8 + 4) = (f32x4){pt[2 * TCH], pt[2 * TCH + 1], 0.f, 0.f};
        }
        for (int it = gw; it < DEPTH * 512; it += NGW) { const int l = it / 512, q = it % 512;
            transpose_item(KIN(19) + (size_t)l * D * 1024, 1024, (q / 32) * 64, (q % 32) * 32, WKVT + (size_t)l * 1024 * 1024, 1024, (q % 32) * 32, cscr, lane); }
    }
    GRID_BAR();
    {
        struct KVOrder { const char* A; const char* B; int G, c;
            __device__ __forceinline__ bool next(int i, pg8::Unit& u) const { const int L = i * G + c; if (L >= 32) return false;
                u.x0 = L >> 3; u.pm = (L >> 2) & 1; u.pn = L & 3; u.x1 = 0; u.A = A + (size_t)u.pm * 256 * 2048; u.B = B + ((size_t)u.x0 * 1024 + (size_t)u.pn * 256) * 2048; return true; } };
        PHASE_PTRS();
        KVOrder S{(const char*)MEMB, (const char*)WKVT, G, bid_l};
        EpiKV E{KB, VT};
        pg8::gemm_phase<EpiKV, KVOrder>(lds, wv, 1024, 1024, 1024, S, E);
    }
    {
        PHASE_IDS(); PHASE_PTRS();
        float* sP = smf;
        float* sC = smf + 2048;
        float* sX = smf + 4096;
        for (int item = bid_l; item < DEPTH * SG * 2; item += G) {
            const int d = item & 1, g = (item >> 1) & 31, l = item >> 6;
            __syncthreads();
            for (int i = tid; i < 1024; i += NT) {
                const int p = i >> 4, k = i & 15; const size_t ti = (size_t)((l * 2 + d) * SG + g) * SP + p;
                sP[i * 2] = PTAB[ti * 34 + 2 * k]; sP[i * 2 + 1] = PTAB[ti * 34 + 2 * k + 1];
                const float fr = S5TAB[ti * 8 + 2], fi = S5TAB[ti * 8 + 3];
                const float br = KIN(8)[((size_t)(l * SG + g) * 64 + p) * 16 + k], bi = KIN(9)[((size_t)(l * SG + g) * 64 + p) * 16 + k];
                sX[i * 2] = fr * br - fi * bi; sX[i * 2 + 1] = fr * bi + fi * br;
                const int h = i >> 6, pp = i & 63;
                sC[i * 2] = KIN(10)[((size_t)(l * SG + g) * 16 + h) * 64 + pp]; sC[i * 2 + 1] = KIN(11)[((size_t)(l * SG + g) * 16 + h) * 64 + pp];
            }
            __syncthreads();
            {
                const int hh = tid & 1, h = (tid >> 1) & 15, tau = tid >> 5;
                float acc[8];
#pragma unroll
                for (int j = 0; j < 8; ++j) acc[j] = 0.f;
                for (int p = 0; p < 64; ++p) {
                    const float cr = sC[(h * 64 + p) * 2], ci = sC[(h * 64 + p) * 2 + 1], pr = sP[(p * 16 + tau) * 2], pi = sP[(p * 16 + tau) * 2 + 1];
                    const float wr = cr * pr - ci * pi, wi = cr * pi + ci * pr;
#pragma unroll
                    for (int j = 0; j < 8; ++j) acc[j] += wr * sX[(p * 16 + hh * 8 + j) * 2] - wi * sX[(p * 16 + hh * 8 + j) * 2 + 1];
                }
                float* o = KTAB + ((((size_t)(l * SG + g) * 2 + d) * TCH + tau) * 16 + h) * 16 + hh * 8;
                *(f32x4*)o = (f32x4){acc[0], acc[1], acc[2], acc[3]}; *(f32x4*)(o + 4) = (f32x4){acc[4], acc[5], acc[6], acc[7]};
            }
        }
        __syncthreads();
    }
    GRID_BAR();
    {
        PHASE_IDS(); PHASE_PTRS();
        const int NE = DEPTH * SG * 256 * 32, NB = DEPTH * SG * 256 * 64;
#pragma unroll 4
        for (int it = bid * NT + tid; it < NE; it += G * NT) {
            float v[8];
            {
                const int kg = it & 31, n = (it >> 5) & 255, g = (it >> 13) & 31, l = it >> 18;
                const int k0 = kg * 8, sp = k0 >> 4, h0 = k0 & 15, d = n >> 7, ri = (n >> 6) & 1, p = n & 63;
                const size_t ti = (size_t)((l * 2 + d) * SG + g) * SP + p;
                const int e = (d == 0) ? (TCH - 1 - sp) : sp;
                const float pr = PTAB[ti * 34 + 2 * e], pi = PTAB[ti * 34 + 2 * e + 1], fr = S5TAB[ti * 8 + 2], fi = S5TAB[ti * 8 + 3];
                const float xr = pr * fr - pi * fi, xi = pr * fi + pi * fr;
                const float* br = KIN(8) + ((size_t)(l * SG + g) * 64 + p) * 16 + h0; const float* bi = KIN(9) + ((size_t)(l * SG + g) * 64 + p) * 16 + h0;
#pragma unroll
                for (int j = 0; j < 8; ++j) v[j] = ri ? (xr * bi[j] + xi * br[j]) : (xr * br[j] - xi * bi[j]);
                u32x4 w; w.x = pk2(v[0], v[1]); w.y = pk2(v[2], v[3]); w.z = pk2(v[4], v[5]); w.w = pk2(v[6], v[7]);
                *(u32x4*)(S5E + ((size_t)(l * SG + g) * 256 + n) * 256 + k0) = w;
            }
        }
#pragma unroll 4
        for (int it = NE + bid * NT + tid; it < NE + NB; it += G * NT) {
            float v[8];
            {
                const int r = it - NE, kg = r & 63, n = (r >> 6) & 255, g = (r >> 14) & 31, l = r >> 19;
                const int k0 = kg * 8, s = n >> 4, h = n & 15;
                if (k0 < 256) {
                    const int sp = k0 >> 4, h0 = k0 & 15;
                    const float* kt = KTAB + (size_t)(l * SG + g) * 2 * TCH * 256;
#pragma unroll
                    for (int j = 0; j < 8; ++j) {
                        float x = 0.f;
                        if (sp <= s) x += kt[(0 * TCH + (s - sp)) * 256 + h * 16 + h0 + j];
                        if (sp >= s) x += kt[(1 * TCH + (sp - s)) * 256 + h * 16 + h0 + j];
                        if (sp == s && h0 + j == h) x += KIN(12)[(size_t)l * SSMW + g * 16 + h];
                        v[j] = x;
                    }
                } else {
                    const int jj = k0 - 256, d = jj >> 7, ri = (jj >> 6) & 1, p0 = jj & 63;
                    const int e = (d == 0) ? (s + 1) : (TCH - s);
                    const float* cre = KIN(10) + ((size_t)(l * SG + g) * 16 + h) * 64 + p0; const float* cim = KIN(11) + ((size_t)(l * SG + g) * 16 + h) * 64 + p0;
#pragma unroll
                    for (int j = 0; j < 8; ++j) {
                        const size_t ti = (size_t)((l * 2 + d) * SG + g) * SP + p0 + j;
                        const float pr = PTAB[ti * 34 + 2 * e], pi = PTAB[ti * 34 + 2 * e + 1], cr = cre[j], ci = cim[j];
                        v[j] = ri ? -(cr * pi + ci * pr) : (cr * pr - ci * pi);
                    }
                }
                u32x4 w; w.x = pk2(v[0], v[1]); w.y = pk2(v[2], v[3]); w.z = pk2(v[4], v[5]); w.w = pk2(v[6], v[7]);
                *(u32x4*)(S5BT + ((size_t)(l * SG + g) * 256 + n) * 512 + k0) = w;
            }
        }
        __syncthreads();
        convert_early_share(ka, 0, (bf16*)(ws + WS_WBE0), bid * 8 + wave, G * 8, (LAS float*)(lds + wave * 16384), lane);
    }
    GRID_BAR();

#pragma unroll 1
    for (int l_iter = 0; l_iter < DEPTH; ++l_iter) {
        {
            PHASE_PTRS(); PHASE_LPTRS();
            pg8::DenseOrder S; S.init(XB, WBE + WE_CAT, M, 5120, D, D, G, bid_l);
            EpiP1 E{UG, GU, GV, QB, GATES, b_gate};
            pg8::gemm_phase<EpiP1, pg8::DenseOrder>(lds, wv, D, D, D, S, E);
        }
        GRID_BAR();

        {
            PHASE_PTRS(); PHASE_LPTRS();
            S5Order S{(const char*)UG, (const char*)(S5E + (size_t)l * SG * 256 * 256), (size_t)256 * 256 * 2, G, bid_l};
            EpiS5St E{SST};
            pg8::gemm_phase<EpiS5St, S5Order>(lds, wv, 512, 256, 256, S, E);
            int bidl = bid; asm volatile("" : "+s"(bidl));
            if (bidl < G / 2) {
                PHASE_IDS(); LAS float* cscr = (LAS float*)(lds + wave * 16384);
                for (int it = bid * 8 + wave; it < 6000; it += (G / 2) * 8) convert_late_item(ka, l, WBL, it, cscr, lane);
            }
            gmlp_phase(lds, wv, GU, GV, WBE + WE_SP, b_sp, gln_g, gln_b, YGMLP, G, bid_l);
        }
        GRID_BAR();
        {
            PHASE_IDS(); PHASE_PTRS(); PHASE_LPTRS();
            for (int item = bid; item < BATCH * SG * 2; item += G) {
                const int d = item & 1, g = (item >> 1) & 31, b = item >> 6, p = lane;
                const f32x4 tb = *(const f32x4*)(S5TAB + ((size_t)((l * 2 + d) * SG + g) * SP + p) * 8 + 4);
                const float ar = tb.x, ai = tb.y;
                const float* sp = SST + ((size_t)g * NCHK + (size_t)b * 512) * 256 + d * 128 + p;
                bf16* ap = UG + ((size_t)g * NCHK + (size_t)b * 512) * 512 + 256 + d * 128 + p;
                const int q0 = wave * 64;
                float hre[64], him[64];
                float hr = 0.f, hi = 0.f;
#pragma unroll
                for (int half = 0; half < 2; ++half) {
                    float sr[32], si[32];
#pragma unroll
                    for (int j = 0; j < 32; ++j) { const int q = q0 + half * 32 + j, c = d ? (511 - q) : q; sr[j] = sp[(size_t)c * 256]; si[j] = sp[(size_t)c * 256 + 64]; }
#pragma unroll
                    for (int j = 0; j < 32; ++j) { hre[half * 32 + j] = hr; him[half * 32 + j] = hi;
                        const float nr = ar * hr - ai * hi + sr[j], ni = ar * hi + ai * hr + si[j]; hr = nr; hi = ni; }
                }
                float* ex = smf + wave * 128;
                __syncthreads();
                ex[lane] = hr; ex[64 + lane] = hi;
                float a64r = ar, a64i = ai;
#pragma unroll
                for (int k = 0; k < 6; ++k) { const float t = a64r * a64r - a64i * a64i; a64i = 2.f * a64r * a64i; a64r = t; }
                __syncthreads();
                float cr = 0.f, ci = 0.f;
                for (int w2 = 0; w2 < wave; ++w2) { const float er = smf[w2 * 128 + lane], ei = smf[w2 * 128 + 64 + lane];
                    const float nr = a64r * cr - a64i * ci + er, ni = a64r * ci + a64i * cr + ei; cr = nr; ci = ni; }
                float pr = 1.f, pi = 0.f;
#pragma unroll
                for (int j = 0; j < 64; ++j) { const int q = q0 + j, c = d ? (511 - q) : q;
                    ap[(size_t)c * 512] = (bf16)f2bf(hre[j] + pr * cr - pi * ci); ap[(size_t)c * 512 + 64] = (bf16)f2bf(him[j] + pr * ci + pi * cr);
                    const float t = pr * ar - pi * ai; pi = pr * ai + pi * ar; pr = t; }
            }
            __syncthreads();
        }
        {
            PHASE_PTRS(); PHASE_LPTRS();
            attn_phase(lds, wv, QB, KB + (size_t)l * 2 * 4 * 256 * 128, VT + (size_t)l * 2 * 4 * 128 * 256, YMEM, G, bid_l);
            int bidl = bid; asm volatile("" : "+s"(bidl));
            if (bidl >= G / 2) {
                PHASE_IDS(); LAS float* cscr = (LAS float*)(lds + wave * 16384);
                for (int it = 6000 + (bid - G / 2) * 8 + wave; it < 6800; it += (G - G / 2) * 8) convert_late_item(ka, l, WBL, it, cscr, lane);
            }
        }
        GRID_BAR();
        {
            PHASE_PTRS(); PHASE_LPTRS();
            S5Order S{(const char*)UG, (const char*)(S5BT + (size_t)l * SG * 256 * 512), (size_t)256 * 512 * 2, G, bid_l};
            EpiS5Out E{YS};
            pg8::gemm_phase<EpiS5Out, S5Order>(lds, wv, 512, 512, 512, S, E);
            int bidl = bid; asm volatile("" : "+s"(bidl));
            {
                PHASE_IDS(); LAS float* cscr = (LAS float*)(lds + wave * 16384);
                if (bidl >= G / 2) { for (int it = 6800 + (bid - G / 2) * 8 + wave; it < CV_LATE; it += (G - G / 2) * 8) convert_late_item(ka, l, WBL, it, cscr, lane); }

            }
        }
        GRID_BAR();

        {
            PHASE_PTRS(); PHASE_LPTRS();
            GluOrder S{(const char*)YS, (const char*)(WBE + WE_GLU), G, bid_l};
            EpiGLU E{YS, YSSM, b_glu};
            pg8::gemm_phase<EpiGLU, GluOrder, false, 1>(lds, wv, 512, 512, 512, S, E);
        }
        GRID_BAR();
        {
            PHASE_PTRS(); PHASE_LPTRS();
            MergeOrder S{(const char*)YSSM, (const char*)YGMLP, (const char*)YMEM, (const char*)(WBE + WE_BR), G, bid_l};
            EpiMergeF E; E.GATES = GATES; E.MERGED = MERGED;
#pragma unroll
            for (int a_ = 0; a_ < 2; ++a_)
#pragma unroll
                for (int m_ = 0; m_ < 4; ++m_) { E.tot[a_][m_][0] = (f32x4){0.f, 0.f, 0.f, 0.f}; E.tot[a_][m_][1] = (f32x4){0.f, 0.f, 0.f, 0.f}; E.gv[a_][m_] = (u32x4){0u, 0u, 0u, 0u}; }
            pg8::gemm_phase<EpiMergeF, MergeOrder, false, 1>(lds, wv, 512, 512, 512, S, E);
        }
        GRID_BAR();
        {
            PHASE_PTRS(); PHASE_LPTRS();
            pg8::DenseOrder S; S.init(MERGED, WBE + WE_OUT, M, D, D, D, G, bid_l);
            EpiOut E{XB, (bf16*)Z1};
            pg8::gemm_phase<EpiOut, pg8::DenseOrder>(lds, wv, D, D, D, S, E);
        }
        GRID_BAR();

        { PHASE_IDS(); PHASE_PTRS(); PHASE_LPTRS(); unsigned* ecnt = ctl + CW_CNT + l * 32 * 64;
        LAS unsigned* lcnt = (LAS unsigned*)(lds + LDS_MISC + 1024); LAS unsigned* lbase = lcnt + 32; LAS int* lrec = (LAS int*)(lcnt + 64);
        const int tpw = (M + G - 1) / G;
        const int vb = bid;
        __syncthreads();
        if (tid < 32) lcnt[tid] = 0u;
        for (int i0 = tid; i0 < 9216; i0 += NT) {
            int i = i0 + (bid >> 3) * 288; if (i >= 9216) i -= 9216;
            const int a = i >> 10, r = i & 1023, pr = (r & ~63) | ((r & 3) << 4) | ((r >> 2) & 15);
            const f32x4 w = (a == 0) ? *(const f32x4*)(w_rg + (size_t)r * 4) : *(const f32x4*)(w_re + ((size_t)((a - 1) >> 1) * D + r) * 8 + ((a - 1) & 1) * 4);
            *(LAS f32x4*)(lds + ((size_t)a * 1024 + pr) * 16) = w;
        }
        __syncthreads();
        const int lrow = (lane >> 4) * 64 + (lane & 15);
        for (int ti0 = wave; ti0 < tpw; ti0 += 16) {
            f32x4 v[2][4]; float s[2], q[2], lg[2][4], le[2][8], pgv[2]; int gs[2], tiv[2], tokv[2]; bool ok[2];
#pragma unroll
            for (int t = 0; t < 2; ++t) {
                tiv[t] = ti0 + 8 * t; tokv[t] = vb * tpw + tiv[t]; ok[t] = (tiv[t] < tpw) && (tokv[t] < M);
                const bf16* zr = (const bf16*)Z1 + (size_t)(ok[t] ? tokv[t] : vb * tpw) * D; s[t] = 0.f;
#pragma unroll
                for (int j = 0; j < 4; ++j) { const u32x2 zw = *(const u32x2*)(zr + j * 256 + lane * 4); v[t][j] = (f32x4){bflo(zw.x), bfhi(zw.x), bflo(zw.y), bfhi(zw.y)}; s[t] += (v[t][j].x + v[t][j].y) + (v[t][j].z + v[t][j].w); }
            }
#pragma unroll
            for (int t = 0; t < 2; ++t) s[t] = wave_sum(s[t], lane) * (1.f / D);
#pragma unroll
            for (int t = 0; t < 2; ++t) { q[t] = 0.f;
#pragma unroll
                for (int j = 0; j < 4; ++j) { v[t][j] = v[t][j] - s[t]; q[t] += (v[t][j].x * v[t][j].x + v[t][j].y * v[t][j].y) + (v[t][j].z * v[t][j].z + v[t][j].w * v[t][j].w); } }
#pragma unroll
            for (int t = 0; t < 2; ++t) q[t] = rsqrtf(wave_sum(q[t], lane) * (1.f / D) + LN_EPS);
#pragma unroll
            for (int t = 0; t < 2; ++t)
#pragma unroll
                for (int g = 0; g < 4; ++g) lg[t][g] = 0.f;
#pragma unroll
            for (int j = 0; j < 4; ++j) {
                const int c0 = j * 256 + lane * 4;
                const f32x4 gg = *(const f32x4*)(ln1_g + c0), bb = *(const f32x4*)(ln1_b + c0);
#pragma unroll
                for (int t = 0; t < 2; ++t) {
                    v[t][j] = v[t][j] * q[t] * gg + bb;
                    if (ok[t]) { u32x2 w; w.x = pk2(v[t][j].x, v[t][j].y); w.y = pk2(v[t][j].z, v[t][j].w); *(u32x2*)(X1B + (size_t)tokv[t] * D + c0) = w; }
                }
#pragma unroll
                for (int e = 0; e < 4; ++e) {
                    const f32x4 wr = *(const LAS f32x4*)(lds + (j * 256 + lrow + 16 * e) * 16);
#pragma unroll
                    for (int t = 0; t < 2; ++t) { const float xv = v[t][j][e]; lg[t][0] += xv * wr.x; lg[t][1] += xv * wr.y; lg[t][2] += xv * wr.z; lg[t][3] += xv * wr.w; }
                }
            }
#pragma unroll
            for (int t = 0; t < 2; ++t) { wave_sum4(lg[t], lane);
#pragma unroll
                for (int g = 0; g < 4; ++g) lg[t][g] += b_rg[g]; }
#pragma unroll
            for (int t = 0; t < 2; ++t) {
                int gsel = 0; float gm = lg[t][0];
#pragma unroll
                for (int g = 1; g < 4; ++g) if (lg[t][g] > gm) { gm = lg[t][g]; gsel = g; }
                float den = 0.f;
#pragma unroll
                for (int g = 0; g < 4; ++g) den += __expf(lg[t][g] - gm);
                pgv[t] = 1.f / den; gs[t] = gsel;
#pragma unroll
                for (int e = 0; e < 8; ++e) le[t][e] = 0.f;
                const LAS unsigned char* wre = lds + 16384 + gsel * 32768;
#pragma unroll
                for (int j = 0; j < 4; ++j) {
#pragma unroll
                    for (int e = 0; e < 4; ++e) {
                        const f32x4 w0 = *(const LAS f32x4*)(wre + (j * 256 + lrow + 16 * e) * 16), w1 = *(const LAS f32x4*)(wre + 16384 + (j * 256 + lrow + 16 * e) * 16);
                        const float xv = v[t][j][e];
                        le[t][0] += xv * w0.x; le[t][1] += xv * w0.y; le[t][2] += xv * w0.z; le[t][3] += xv * w0.w;
                        le[t][4] += xv * w1.x; le[t][5] += xv * w1.y; le[t][6] += xv * w1.z; le[t][7] += xv * w1.w;
                    }
                }
            }
#pragma unroll
            for (int t = 0; t < 2; ++t) { wave_sum8(le[t], lane);
#pragma unroll
                for (int e = 0; e < 8; ++e) le[t][e] += b_re[gs[t] * 8 + e]; }
#pragma unroll
            for (int t = 0; t < 2; ++t) {
                int i0 = 0; float v0 = le[t][0];
#pragma unroll
                for (int e = 1; e < 8; ++e) if (le[t][e] > v0) { v0 = le[t][e]; i0 = e; }
                int i1 = -1; float v1 = -3.0e38f;
#pragma unroll
                for (int e = 0; e < 8; ++e) if (e != i0 && le[t][e] > v1) { v1 = le[t][e]; i1 = e; }
                const float p0 = 1.f / (1.f + __expf(v1 - v0)), p1 = 1.f - p0;
                if (lane == 0 && ok[t]) {
                    const int e0 = gs[t] * 8 + i0, e1 = gs[t] * 8 + i1;
                    const unsigned q0 = __hip_atomic_fetch_add(lcnt + e0, 1u, __ATOMIC_RELAXED, __HIP_MEMORY_SCOPE_WORKGROUP), q1 = __hip_atomic_fetch_add(lcnt + e1, 1u, __ATOMIC_RELAXED, __HIP_MEMORY_SCOPE_WORKGROUP);
                    lrec[tiv[t] * 4 + 0] = e0; lrec[tiv[t] * 4 + 1] = e1; lrec[tiv[t] * 4 + 2] = (int)q0; lrec[tiv[t] * 4 + 3] = (int)q1;
                    TOKW[tokv[t] * 2] = pgv[t] * p0; TOKW[tokv[t] * 2 + 1] = pgv[t] * p1;
                }
            }
        }
        __syncthreads();
        if (tid < 32) { const unsigned n = lcnt[tid]; lbase[tid] = n ? atomicAdd(&ecnt[tid * 64], n) : 0u; }
        __syncthreads();
        for (int ti = tid; ti < tpw; ti += NT) { const int tok = vb * tpw + ti;
            if (tok < M) { const int e0 = lrec[ti * 4], e1 = lrec[ti * 4 + 1];
                LIST[(size_t)e0 * LCAP + lbase[e0] + lrec[ti * 4 + 2]] = tok * 2; LIST[(size_t)e1 * LCAP + lbase[e1] + lrec[ti * 4 + 3]] = tok * 2 + 1; } }
        __syncthreads();
        }
        GRID_BAR();

        if (opaque_tid(wv) == 0) {
            PHASE_PTRS(); PHASE_LPTRS(); unsigned* ecnt = ctl + CW_CNT + l * 32 * 64;
            int tb = 0, sb = 0;
            for (int e = 0; e < NEXP; ++e) { const int cnt = (int)xb_ld(&ecnt[e * 64]); const int nrt = (cnt + 255) >> 8; mtab->tb[e] = tb; mtab->sb[e] = sb; mtab->cn[e] = cnt; tb += nrt; sb += nrt * 256; }
            mtab->tb[32] = tb; mtab->sb[32] = sb;
        }
        __syncthreads();
        {
            PHASE_PTRS(); PHASE_LPTRS();
            const int NX = (G % 8 == 0) ? 8 : 1, Gx = G / NX, x = bid_l % NX, kx = bid_l / NX;
            const int Tx = moe_ntile_x(mtab, x, NX), NGU = 2 * Tx;
            unsigned* tcnt = ctl + CW_TC + (size_t)l * 160 * 64;
#define MOE_GU_UNIT(lu_) do { const int lu = (lu_); int e, pm; moe_local_tile(mtab, x, NX, lu >> 1, e, pm); \
                const int cnt = __builtin_amdgcn_readfirstlane(mtab->cn[e]), t = __builtin_amdgcn_readfirstlane(mtab->tb[e]) + pm; \
                MoeOrderGU S{(const char*)X1B, (const char*)(WBL + WL_GU), LIST, e, pm, cnt, lu & 1}; \
                EpiMoeGU E; E.T = mtab; E.LIST = LIST; E.TOKW = TOKW; E.HB = HB; E.init(e, pm, cnt, opaque_tid(wv)); \
                pg8::gemm_phase<EpiMoeGU, MoeOrderGU, true>(lds, wv, D, D, D, S, E); \
                  \
                if (opaque_tid(wv) == 0) { __builtin_amdgcn_fence(__ATOMIC_RELEASE, "agent"); asm volatile("s_waitcnt vmcnt(0)" ::: "memory"); (void)xb_add(&tcnt[t * 64], 1u); } } while (0)
            if (kx < NGU) MOE_GU_UNIT(kx);
#pragma unroll 1
            for (int lu2 = kx + Gx; lu2 < NGU; lu2 += Gx) MOE_GU_UNIT(lu2);
#undef MOE_GU_UNIT
            {
                const int R2 = (NGU > Gx) ? (NGU - Gx) : 0;
                int j, We;
                if (R2 < Gx) { We = Gx - R2; j = kx - R2; } else { We = Gx; j = kx; }
                const int Te = (R2 < Gx) ? ((Tx < Gx / 2) ? Tx : (Gx / 2)) : 0, NDe = 4 * Te, ND = 4 * Tx;
#define MOE_D_CALL(d0_, d1_) do { const int dd0 = (d0_), dd1 = (d1_); \
                if (j >= 0 && dd0 < dd1) { \
                    if (opaque_tid(wv) == 0) { unsigned* bw = ctl + CW_BAR; \
                        for (int du = dd0; du < dd1; du += We) { int e, pm; moe_local_tile(mtab, x, NX, du >> 2, e, pm); const int t = mtab->tb[e] + pm; XB_SPIN(xb_ld(&tcnt[t * 64]) < 2u, bw); } \
                        __builtin_amdgcn_fence(__ATOMIC_ACQUIRE, "agent"); asm volatile("s_waitcnt vmcnt(0)" ::: "memory"); } \
                    __syncthreads(); \
                    MoeOrderD S{mtab, (const char*)HB, (const char*)(WBL + WL_D), x, NX, dd0, We, dd1}; \
                    EpiMoeD E; E.LIST = LIST; E.O2 = O2; _Pragma("unroll") for (int a_ = 0; a_ < 2; ++a_) _Pragma("unroll") for (int m_ = 0; m_ < 4; ++m_) E.pr[a_][m_] = 0; \
                    pg8::gemm_phase<EpiMoeD, MoeOrderD>(lds, wv, DEXP, DEXP, DEXP, S, E); } } while (0)
                MOE_D_CALL(j, NDe);
                MOE_D_CALL(NDe + j, ND);
#undef MOE_D_CALL
            }
            if (l + 1 < DEPTH) {
                PHASE_IDS();
                convert_early_share(ka, l + 1, (bf16*)(ws + (((l + 1) & 1) ? WS_WBE1 : WS_WBE0)), bid_l * 8 + wave, G * 8, (LAS float*)(lds + wave * 16384), lane);
            }
        }
        GRID_BAR();

        { PHASE_IDS(); PHASE_PTRS(); PHASE_LPTRS();
        float* outp = *(float* const __attribute__((address_space(4)))*)(ka + 264);
        for (int tok0 = bid * 8 + wave; tok0 < M; tok0 += G * 16) {
            f32x4 v[2][4]; float s[2], q[2]; int tk[2];
#pragma unroll
            for (int t = 0; t < 2; ++t) {
                tk[t] = tok0 + t * G * 8; const int tok = (tk[t] < M) ? tk[t] : tok0; s[t] = 0.f;
                const bf16* xr = X1B + (size_t)tok * D;
#pragma unroll
                for (int j = 0; j < 4; ++j) {
                    const int c0 = j * 256 + lane * 4;
                    const u32x2 xw = *(const u32x2*)(xr + c0);
                    const u32x2 a = *(const u32x2*)(O2 + (size_t)(tok * 2) * D + c0), b = *(const u32x2*)(O2 + (size_t)(tok * 2 + 1) * D + c0);
                    v[t][j].x = ALPHA * bflo(xw.x) + bflo(a.x) + bflo(b.x); v[t][j].y = ALPHA * bfhi(xw.x) + bfhi(a.x) + bfhi(b.x);
                    v[t][j].z = ALPHA * bflo(xw.y) + bflo(a.y) + bflo(b.y); v[t][j].w = ALPHA * bfhi(xw.y) + bfhi(a.y) + bfhi(b.y);
                    s[t] += (v[t][j].x + v[t][j].y) + (v[t][j].z + v[t][j].w);
                }
            }
#pragma unroll
            for (int t = 0; t < 2; ++t) s[t] = wave_sum(s[t], lane) * (1.f / D);
#pragma unroll
            for (int t = 0; t < 2; ++t) { q[t] = 0.f;
#pragma unroll
                for (int j = 0; j < 4; ++j) { v[t][j] = v[t][j] - s[t]; q[t] += (v[t][j].x * v[t][j].x + v[t][j].y * v[t][j].y) + (v[t][j].z * v[t][j].z + v[t][j].w * v[t][j].w); } }
#pragma unroll
            for (int t = 0; t < 2; ++t) q[t] = rsqrtf(wave_sum(q[t], lane) * (1.f / D) + LN_EPS);
#pragma unroll
            for (int t = 0; t < 2; ++t) {
                if (tk[t] < M) {
#pragma unroll
                    for (int j = 0; j < 4; ++j) {
                        const int c0 = j * 256 + lane * 4;
                        const f32x4 gg = *(const f32x4*)(ln2_g + c0), bb = *(const f32x4*)(ln2_b + c0);
                        const f32x4 o = v[t][j] * q[t] * gg + bb;
                        if (l == DEPTH - 1) *(f32x4*)(outp + (size_t)tk[t] * D + c0) = o;
                        else { u32x2 w; w.x = pk2(o.x, o.y); w.y = pk2(o.z, o.w); *(u32x2*)(XB + (size_t)tk[t] * D + c0) = w; }
                    }
                }
            }
        } }
        if (l_iter != DEPTH - 1) GRID_BAR();
    }
}

extern "C" void kernel_launch(void* const* d_in, const int* in_sizes, int n_in, void* d_out, int out_size, void* d_ws, size_t ws_size, hipStream_t stream) {
    static int grid = 0;
    if (grid == 0) {
        if (n_in != 33 || out_size != M * D || ws_size < WS_END) { fprintf(stderr, "kernel_launch: unexpected shapes n_in %d out %d ws %zu (need %zu)\n", n_in, out_size, ws_size, (size_t)WS_END); grid = -1; return; }
        int dev = 0, cus = 0, per_cu = 0;
        if (hipGetDevice(&dev) != hipSuccess || hipDeviceGetAttribute(&cus, hipDeviceAttributeMultiprocessorCount, dev) != hipSuccess) { grid = -1; return; }
        if (hipFuncSetAttribute((const void*)fwd_kernel, hipFuncAttributeMaxDynamicSharedMemorySize, LDS_BYTES) != hipSuccess) { fprintf(stderr, "kernel_launch: hipFuncSetAttribute failed\n"); grid = -1; return; }
        if (hipOccupancyMaxActiveBlocksPerMultiprocessor(&per_cu, (const void*)fwd_kernel, NT, LDS_BYTES) != hipSuccess || per_cu < 1) { fprintf(stderr, "kernel_launch: occupancy query says %d\n", per_cu); per_cu = 1; }
        (void)hipGetLastError();
        grid = cus;
        if (grid < 160) { fprintf(stderr, "kernel_launch: built for a grid of >= 160 workgroups (MoE phase: one row tile per workgroup); device has %d CUs\n", cus); grid = -1; return; }
    }
    if (grid < 0) return;
    (void)hipMemsetAsync((char*)d_ws + WS_CTL, 0, CTL_ZERO_BYTES, stream);
    Args a{};
    for (int i = 0; i < 33; ++i) a.in[i] = (const float*)d_in[i];
    a.out = (float*)d_out; a.ws = (unsigned char*)d_ws;
    hipLaunchKernelGGL(fwd_kernel, dim3(grid), dim3(NT), LDS_BYTES, stream, a);
}
```

```cpp
#include <hip/hip_runtime.h>
#include <cstdio>
#include <cstdint>

#define LAS __attribute__((address_space(3)))
typedef unsigned short bf16;
typedef float f32x4 __attribute__((ext_vector_type(4)));
typedef float f32x2 __attribute__((ext_vector_type(2)));
typedef unsigned u32x4 __attribute__((ext_vector_type(4)));
typedef unsigned u32x2 __attribute__((ext_vector_type(2)));

constexpr int D = 1024, BATCH = 2, SEQ = 8192, M = BATCH * SEQ, DEPTH = 4;
constexpr int NMEM = 256, SSMW = 512, SG = 32, SGC = 16, SP = 64;
constexpr int GW = 512, GG = 8, GGC = 64, CHUNK = 128;
constexpr int MH = 4, MW = 512, MHD = 128;
constexpr int INW = 2048, NGATE = 3072;
constexpr int NGRP = 4, EPG = 8, NEXP = 32, DEXP = 256;
constexpr float ALPHA = 1.6817928305074290f;
constexpr float LN_EPS = 1e-5f;
constexpr int LCAP = 16640;
constexpr int SPCAP = 41216;

constexpr size_t MiB = 1u << 20;
constexpr size_t WS_CTL = 0, CTL_ZERO_BYTES = 1 * MiB;
constexpr size_t WS_X32 = 1 * MiB;
constexpr size_t WS_XB = 65 * MiB;
constexpr size_t WS_Z1 = 97 * MiB;
constexpr size_t WS_AEXT = 161 * MiB;
constexpr size_t WS_T0 = WS_AEXT;
constexpr size_t WS_X1B = WS_AEXT;
constexpr size_t WS_GU = 193 * MiB;
constexpr size_t WS_GV = 209 * MiB;
constexpr size_t WS_Q = 225 * MiB;
constexpr size_t WS_T1 = WS_GV;
constexpr size_t WS_GATES = 241 * MiB;
constexpr size_t WS_O2 = WS_GATES;
constexpr size_t WS_YS = 337 * MiB;
constexpr size_t WS_YSSM = 353 * MiB;
constexpr size_t WS_YGMLP = 369 * MiB;
constexpr size_t WS_YMEM = 385 * MiB;
constexpr size_t WS_MERGED = 401 * MiB;
constexpr size_t WS_SST = WS_MERGED;
constexpr size_t WS_KB = 433 * MiB;
constexpr size_t WS_VT = 435 * MiB;
constexpr size_t WS_HB = 437 * MiB;
constexpr size_t WS_LIST = 458 * MiB;
constexpr size_t WS_TOKW = 461 * MiB;
constexpr size_t WS_S5TAB = 461 * MiB + 512 * 1024;
constexpr size_t WS_WBE0 = 462 * MiB;
constexpr size_t WS_WBL = 478 * MiB;
constexpr size_t WS_WBE1 = 574 * MiB;
constexpr size_t WS_S5E = 526 * MiB;
constexpr size_t WS_S5BT = 542 * MiB;
constexpr size_t WS_END = 590 * MiB;
constexpr size_t WS_PTAB = WS_Z1;
constexpr size_t WS_KTAB = WS_Z1 + 4 * MiB;
constexpr int TCH = 16, NCHK = M / TCH;
constexpr int CW_DBG = 8;
constexpr int CW_CNT = 16384;
constexpr int CW_BAR = 4096;
constexpr int CW_TC = 65536;

__device__ __forceinline__ unsigned f2bf(float f) { unsigned u = __builtin_bit_cast(unsigned, f); return (u + 0x7fffu + ((u >> 16) & 1u)) >> 16; }
__device__ __forceinline__ float bf2f(unsigned short b) { return __builtin_bit_cast(float, (unsigned)b << 16); }
__device__ __forceinline__ float bflo(unsigned w) { return __builtin_bit_cast(float, w << 16); }
__device__ __forceinline__ float bfhi(unsigned w) { return __builtin_bit_cast(float, w & 0xffff0000u); }
__device__ __forceinline__ unsigned pk2(float lo, float hi) { return f2bf(lo) | (f2bf(hi) << 16); }
__device__ __forceinline__ float gelu_tanh(float x) { const float u = 0.7978845608028654f * (x + 0.044715f * x * x * x); return 0.5f * x * (1.f + tanhf(u)); }
__device__ __forceinline__ float sigmoidf_(float x) { return 1.f / (1.f + __expf(-x)); }
__device__ __forceinline__ float lane_xor(float v, int lane, int m) { return __builtin_bit_cast(float, __builtin_amdgcn_ds_bpermute((lane ^ m) << 2, __builtin_bit_cast(int, v))); }
__device__ __forceinline__ float wave_sum(float v, int lane) {
#pragma unroll
    for (int o = 1; o < 64; o <<= 1) v += lane_xor(v, lane, o);
    return v;
}
__device__ __forceinline__ float wave_max(float v, int lane) {
#pragma unroll
    for (int o = 1; o < 64; o <<= 1) v = fmaxf(v, lane_xor(v, lane, o));
    return v;
}

__device__ __forceinline__ void wave_sum4(float (&v)[4], int lane) {
    const bool b5 = (lane & 32) != 0, b4 = (lane & 16) != 0;
    float k0 = b5 ? v[2] : v[0], k1 = b5 ? v[3] : v[1]; const float s0 = b5 ? v[0] : v[2], s1 = b5 ? v[1] : v[3];
    k0 += lane_xor(s0, lane, 32); k1 += lane_xor(s1, lane, 32);
    float k = b4 ? k1 : k0; const float s = b4 ? k0 : k1;
    k += lane_xor(s, lane, 16);
    k += lane_xor(k, lane, 8); k += lane_xor(k, lane, 4); k += lane_xor(k, lane, 2); k += lane_xor(k, lane, 1);
    const int ki = __builtin_bit_cast(int, k);
    v[0] = __builtin_bit_cast(float, __builtin_amdgcn_readlane(ki, 0)); v[1] = __builtin_bit_cast(float, __builtin_amdgcn_readlane(ki, 16));
    v[2] = __builtin_bit_cast(float, __builtin_amdgcn_readlane(ki, 32)); v[3] = __builtin_bit_cast(float, __builtin_amdgcn_readlane(ki, 48));
}
__device__ __forceinline__ void wave_sum8(float (&v)[8], int lane) {
    const bool b5 = (lane & 32) != 0, b4 = (lane & 16) != 0, b3 = (lane & 8) != 0;
    float k[4], s[4];
#pragma unroll
    for (int i = 0; i < 4; ++i) { k[i] = b5 ? v[4 + i] : v[i]; s[i] = b5 ? v[i] : v[4 + i]; }
#pragma unroll
    for (int i = 0; i < 4; ++i) k[i] += lane_xor(s[i], lane, 32);
    float k2[2], s2[2];
#pragma unroll
    for (int i = 0; i < 2; ++i) { k2[i] = b4 ? k[2 + i] : k[i]; s2[i] = b4 ? k[i] : k[2 + i]; }
#pragma unroll
    for (int i = 0; i < 2; ++i) k2[i] += lane_xor(s2[i], lane, 16);
    float kk = b3 ? k2[1] : k2[0]; const float ss = b3 ? k2[0] : k2[1];
    kk += lane_xor(ss, lane, 8);
    kk += lane_xor(kk, lane, 4); kk += lane_xor(kk, lane, 2); kk += lane_xor(kk, lane, 1);
    const int ki = __builtin_bit_cast(int, kk);
    v[0] = __builtin_bit_cast(float, __builtin_amdgcn_readlane(ki, 0)); v[1] = __builtin_bit_cast(float, __builtin_amdgcn_readlane(ki, 8));
    v[2] = __builtin_bit_cast(float, __builtin_amdgcn_readlane(ki, 16)); v[3] = __builtin_bit_cast(float, __builtin_amdgcn_readlane(ki, 24));
    v[4] = __builtin_bit_cast(float, __builtin_amdgcn_readlane(ki, 32)); v[5] = __builtin_bit_cast(float, __builtin_amdgcn_readlane(ki, 40));
    v[6] = __builtin_bit_cast(float, __builtin_amdgcn_readlane(ki, 48)); v[7] = __builtin_bit_cast(float, __builtin_amdgcn_readlane(ki, 56));
}

#define XB_TMO      128
#define XB_XCNT(j)  (256  + 64 * (j))
#define XB_XSUB(j)  (1280 + 64 * (j))
#define XB_XGEN(j)  (2304 + 64 * (j))
#define XB_TOP      3328
#define XB_TOPGEN   3392
#define XCD_BAR_WORDS 3456
#define XB_SPIN_CAP (1u << 22)

__device__ __forceinline__ unsigned xb_ld(unsigned* p)              { return __hip_atomic_load(p, __ATOMIC_RELAXED, __HIP_MEMORY_SCOPE_AGENT); }
__device__ __forceinline__ unsigned xb_add(unsigned* p, unsigned v) { return __hip_atomic_fetch_add(p, v, __ATOMIC_RELAXED, __HIP_MEMORY_SCOPE_AGENT); }
__device__ __forceinline__ unsigned xb_xcc_id() { return (unsigned)__builtin_amdgcn_s_getreg((3 << 11) | 20) & 0xFu; }
#define XB_SPIN(cond, bar) do { unsigned _sp = 0; while (cond) { __builtin_amdgcn_s_sleep(1); \
    if ((++_sp & 255u) == 0u) { if (xb_ld(&(bar)[XB_TMO])) break; if (_sp > XB_SPIN_CAP) { atomicAdd(&(bar)[XB_TMO], 1u); break; } } } } while (0)

struct XcdBarrier { unsigned* bar; unsigned x; volatile LAS unsigned* st; };

__device__ __forceinline__ XcdBarrier xcd_barrier_post(unsigned* bar, volatile LAS unsigned* st) {
    XcdBarrier b; b.bar = bar; b.x = xb_xcc_id(); b.st = st;
    if (threadIdx.x == 0) (void)xb_add(&bar[XB_XCNT(b.x)], 1u);
    return b;
}
__device__ __forceinline__ void xcd_barrier_complete(unsigned* bar, unsigned x, unsigned& nloc, unsigned& nx) {
    const unsigned G = gridDim.x * gridDim.y * gridDim.z;
    unsigned sum, cnt, mine, sp = 0u;
    for (;;) {
        sum = 0u; cnt = 0u; mine = 0u;
#pragma unroll
        for (unsigned j = 0; j < 16; ++j) { const unsigned c = xb_ld(&bar[XB_XCNT(j)]); sum += c; cnt += (c > 0u) ? 1u : 0u; }
        mine = xb_ld(&bar[XB_XCNT(x)]);
        if (sum == G) break;
        __builtin_amdgcn_s_sleep(1);
        if ((++sp & 255u) == 0u) { if (xb_ld(&bar[XB_TMO])) break; if (sp > XB_SPIN_CAP) { atomicAdd(&bar[XB_TMO], 1u); break; } }
    }
    nloc = mine > 0u ? mine : 1u; nx = cnt > 0u ? cnt : 1u;
}
__device__ __forceinline__ void xcd_barrier(const XcdBarrier& b, const bool leader) {
    asm volatile("s_waitcnt vmcnt(0)" ::: "memory");
    __syncthreads();
    if (leader) {
        unsigned* bar = b.bar;
        unsigned bx = xb_xcc_id(); asm volatile("" : "+s"(bx));
        __builtin_amdgcn_s_waitcnt(0);
        unsigned nloc = b.st[0], nx = b.st[1];
        if (nloc == 0u) { xcd_barrier_complete(bar, bx, nloc, nx); b.st[0] = nloc; b.st[1] = nx; }
        const unsigned old = xb_add(&bar[XB_XSUB(bx)], 1u);
        const unsigned gen = old / nloc;
        if (old + 1u == (gen + 1u) * nloc) {
            __builtin_amdgcn_fence(__ATOMIC_RELEASE, "agent");
            asm volatile("s_waitcnt vmcnt(0)" ::: "memory");
            const unsigned og = xb_add(&bar[XB_TOP], 1u);
            const unsigned tg = og / nx;
            if (og + 1u == (tg + 1u) * nx) xb_add(&bar[XB_TOPGEN], 1u);
            else XB_SPIN(xb_ld(&bar[XB_TOPGEN]) == tg, bar);
            __builtin_amdgcn_fence(__ATOMIC_ACQUIRE, "agent");
            xb_add(&bar[XB_XGEN(bx)], 1u);
            asm volatile("s_waitcnt vmcnt(0)" ::: "memory");
        } else {
            XB_SPIN(xb_ld(&bar[XB_XGEN(bx)]) == gen, bar);
            __builtin_amdgcn_fence(__ATOMIC_ACQUIRE, "agent");
            asm volatile("s_waitcnt vmcnt(0)" ::: "memory");
        }
    }
    __syncthreads();
}

constexpr int LDS_BYTES = 151552;
constexpr int LDS_MISC = 147456;
constexpr int NT = 512;
constexpr int LDS_GOFF = 131072;

__device__ __forceinline__ int opaque_tid(const int wv) { int t = wv * 64 + (int)__builtin_amdgcn_mbcnt_hi(~0u, __builtin_amdgcn_mbcnt_lo(~0u, 0u)); asm volatile("" : "+v"(t)); return t; }
namespace pg8 {
typedef short bf16x8 __attribute__((ext_vector_type(8)));
constexpr int BM = 256, BK = 64, HALF = 128, HTB = HALF * BK * 2, STAGE_BYTES = 8 * HTB, NXCD = 8, WGM = 8;
__device__ __forceinline__ int lds_byte(int r, int c) { const int st = (r >> 4) * 2 + (c >> 5), rr = r & 15, cc = c & 31, ob = rr * 64 + cc * 2; return st * 1024 + (ob ^ (((ob >> 9) & 1) << 5)); }
__device__ __forceinline__ void stage_rc(int b, int& R, int& C) { const int st = b / 1024, sb = b % 1024, swz = sb ^ (((sb >> 9) & 1) << 5); R = (st >> 1) * 16 + swz / 64; C = (st & 1) * 32 + (swz % 64) / 2; }
__device__ __forceinline__ int perm32(int rho) { const int n = rho >> 4, i = rho & 15; return 8 * (i >> 2) + 4 * n + (i & 3); }

struct Unit { const char* A; const char* B; int pm, pn, x0, x1; };

template <class Epi, class Sched, bool GATHER = false, int NBH = 2>
__device__ __forceinline__ void gemm_phase(LAS unsigned char* lds, const int wv, const int lda, const int ldb, const int K, const Sched& S, Epi& E) {
    const int tid = opaque_tid(wv);
    const int wid = __builtin_amdgcn_readfirstlane(tid >> 6), lane = tid & 63, wr = wid >> 2, wc = wid & 3, fr = lane & 15, fq = lane >> 4;
    const int nt = K / BK;
    int sR[2], sC2[2]; unsigned voffB[2];
#pragma unroll
    for (int i = 0; i < 2; ++i) { int R, C; stage_rc(tid * 16 + i * 8192, R, C); const int Rb = Epi::PERM ? ((R & ~31) + perm32(R & 31)) : R;
        sR[i] = R; sC2[i] = C * 2; voffB[i] = (unsigned)(Rb * ldb + C) * 2u; }
    const size_t kstep = (size_t)(BK * 2);
    const unsigned hstepA = (unsigned)HALF * (unsigned)lda * 2u;
    const size_t hstepB = (size_t)HALF * ldb * 2;
    const unsigned ldsw = (unsigned)wid * 1024u;
    const int aoff = lds_byte(wr * 64 + fr, fq * 8), boff = lds_byte(wc * 32 + fr, fq * 8);
#define PG8_SA(b, h) (((b) * 2 + (h)) * HTB)
#define PG8_SB(b, h) ((4 + (b) * 2 + (h)) * HTB)
#define PG8_STAGE2(bufoff, gbase, v0, v1) do { \
        __builtin_amdgcn_global_load_lds((const unsigned*)((const char*)(gbase) + (v0)), (LAS unsigned*)(lds + (bufoff) + ldsw), 16, 0, 0); \
        __builtin_amdgcn_global_load_lds((const unsigned*)((const char*)(gbase) + (v1)), (LAS unsigned*)(lds + (bufoff) + ldsw + 8192), 16, 0, 0); } while (0)
#define PG8_STAGEB(bufoff, gbase) PG8_STAGE2(bufoff, gbase, voffB[0], voffB[1])
#define PG8_LDA(dst, b, h) do { _Pragma("unroll") for (int m = 0; m < 4; ++m) _Pragma("unroll") for (int k = 0; k < 2; ++k) dst[m][k] = *(const LAS bf16x8*)(lds + PG8_SA(b, h) + aoff + m * 2048 + k * 1024); } while (0)
#define PG8_LDB(dst, b, h) do { _Pragma("unroll") for (int n = 0; n < 2; ++n) _Pragma("unroll") for (int k = 0; k < 2; ++k) dst[n][k] = *(const LAS bf16x8*)(lds + PG8_SB(b, h) + boff + n * 2048 + k * 1024); } while (0)
#define PG8_MMA(ai, bj, At, Bt) do { __builtin_amdgcn_s_setprio(1); _Pragma("unroll") for (int m = 0; m < 4; ++m) _Pragma("unroll") for (int n = 0; n < 2; ++n) _Pragma("unroll") for (int k = 0; k < 2; ++k) \
        acc[ai][bj][m][n] = __builtin_amdgcn_mfma_f32_16x16x32_bf16(Bt[n][k], At[m][k], acc[ai][bj][m][n], 0, 0, 0); __builtin_amdgcn_s_setprio(0); } while (0)
#define PG8_WAIT_V(n) asm volatile("s_waitcnt vmcnt(" #n ")" ::: "memory")
#define PG8_WAIT_L(n) asm volatile("s_waitcnt lgkmcnt(" #n ")" ::: "memory")
#define PG8_BAR __builtin_amdgcn_s_barrier()
#define PG8_SCHED __builtin_amdgcn_sched_barrier(0)
    Unit cur, nxt; int ui = 0;
    if (!S.next(0, cur)) return;
    f32x4 acc[2][NBH][4][2];
#pragma unroll
    for (int a = 0; a < 2; ++a)
#pragma unroll
        for (int b = 0; b < NBH; ++b)
#pragma unroll
            for (int m = 0; m < 4; ++m)
#pragma unroll
                for (int n = 0; n < 2; ++n) acc[a][b][m][n] = (f32x4){0.f, 0.f, 0.f, 0.f};
    bf16x8 At[4][2], B0[2][2], B1[2][2];
    unsigned voffA[2]; unsigned ga[2][2];
#pragma unroll
    for (int i = 0; i < 2; ++i) voffA[i] = (unsigned)(sR[i] * lda) * 2u + (unsigned)sC2[i];
    if constexpr (GATHER) {
#pragma unroll
        for (int i = 0; i < 2; ++i) { ga[0][i] = S.row_off(cur, sR[i]) + (unsigned)sC2[i]; ga[1][i] = S.row_off(cur, HALF + sR[i]) + (unsigned)sC2[i]; }
    }
#define PG8_STAGEA(bufoff, gbase, h, nx) do { if constexpr (GATHER) { PG8_STAGE2(bufoff, gbase, ga[h][0], ga[h][1]); } \
        else { PG8_STAGE2(bufoff, (gbase) + (h) * (size_t)hstepA, voffA[0], voffA[1]); } } while (0)
    const char* cA = cur.A; const char* cB = cur.B;
    if constexpr (Epi::HAS_PRE) { const int t3 = opaque_tid(wv) & 63; E.pre(cur, wr, wc, t3 & 15, t3 >> 4); }
    if constexpr (NBH == 2) {
        PG8_STAGEB(PG8_SB(0, 0), cB); PG8_STAGEB(PG8_SB(0, 1), cB + hstepB); PG8_STAGEA(PG8_SA(0, 0), cA, 0, false); PG8_STAGEA(PG8_SA(0, 1), cA, 1, false);
        if (wr == 1) PG8_BAR;
        PG8_WAIT_V(2); PG8_BAR;
        PG8_STAGEB(PG8_SB(1, 0), cB + kstep); PG8_STAGEA(PG8_SA(1, 0), cA + kstep, 0, false); PG8_STAGEB(PG8_SB(1, 1), cB + hstepB + kstep);
        PG8_WAIT_V(6); PG8_BAR;
    } else {
        PG8_STAGEB(PG8_SB(0, 0), cB); PG8_STAGEA(PG8_SA(0, 0), cA, 0, false); PG8_STAGEA(PG8_SA(0, 1), cA, 1, false);
        if (wr == 1) PG8_BAR;
        PG8_WAIT_V(2); PG8_BAR;
        PG8_STAGEB(PG8_SB(1, 0), cB + kstep); PG8_STAGEA(PG8_SA(1, 0), cA + kstep, 0, false);
        PG8_WAIT_V(4); PG8_BAR;
    }
#pragma unroll 1
    for (;;) {
        const bool has_next = S.next(ui + 1, nxt);
        const char* nA = has_next ? nxt.A : cA; const char* nB = has_next ? nxt.B : cB;
#pragma unroll 1
        for (int t = 0; t < nt; t += 2) {
            const bool last = (t == nt - 2);
            const char* a1 = cA + (size_t)(t + 1) * kstep;
            const char* a2 = last ? nA : cA + (size_t)(t + 2) * kstep; const char* b2 = last ? nB : cB + (size_t)(t + 2) * kstep;
            const char* a3 = a2 + kstep; const char* b3 = b2 + kstep;
            if constexpr (NBH == 2) {
            PG8_LDB(B0, 0, 0); PG8_LDB(B1, 0, 1); PG8_SCHED; PG8_LDA(At, 0, 0); PG8_STAGEA(PG8_SA(1, 1), a1, 1, false);
            PG8_WAIT_V(8); PG8_WAIT_L(0); PG8_BAR; PG8_MMA(0, 0, At, B0); PG8_MMA(0, 1, At, B1); PG8_BAR; PG8_SCHED;
            PG8_LDA(At, 0, 1); PG8_STAGEB(PG8_SB(0, 0), b2); PG8_STAGEB(PG8_SB(0, 1), b2 + hstepB); PG8_STAGEA(PG8_SA(0, 0), a2, 0, last);
            PG8_WAIT_V(8); PG8_WAIT_L(0); PG8_BAR; PG8_MMA(1, 0, At, B0); PG8_MMA(1, 1, At, B1); PG8_BAR; PG8_SCHED;
            PG8_LDB(B0, 1, 0); PG8_LDB(B1, 1, 1); PG8_SCHED; PG8_LDA(At, 1, 0); PG8_STAGEA(PG8_SA(0, 1), a2, 1, last);
            PG8_WAIT_V(8); PG8_WAIT_L(0); PG8_BAR; PG8_MMA(0, 0, At, B0); PG8_MMA(0, 1, At, B1); PG8_BAR; PG8_SCHED;
            PG8_LDA(At, 1, 1); PG8_STAGEB(PG8_SB(1, 0), b3); PG8_STAGEB(PG8_SB(1, 1), b3 + hstepB); PG8_STAGEA(PG8_SA(1, 0), a3, 0, last);
            PG8_WAIT_V(8); PG8_WAIT_L(0); PG8_BAR; PG8_MMA(1, 0, At, B0); PG8_MMA(1, 1, At, B1); PG8_BAR; PG8_SCHED;
            } else {
            PG8_LDB(B0, 0, 0); PG8_SCHED; PG8_LDA(At, 0, 0); PG8_STAGEA(PG8_SA(1, 1), a1, 1, false);
            PG8_WAIT_V(6); PG8_WAIT_L(0); PG8_BAR; PG8_MMA(0, 0, At, B0); PG8_BAR; PG8_SCHED;
            PG8_LDA(At, 0, 1); PG8_STAGEB(PG8_SB(0, 0), b2); PG8_STAGEA(PG8_SA(0, 0), a2, 0, last);
            PG8_WAIT_V(6); PG8_WAIT_L(0); PG8_BAR; PG8_MMA(1, 0, At, B0); PG8_BAR; PG8_SCHED;
            PG8_LDB(B0, 1, 0); PG8_SCHED; PG8_LDA(At, 1, 0); PG8_STAGEA(PG8_SA(0, 1), a2, 1, last);
            PG8_WAIT_V(6); PG8_WAIT_L(0); PG8_BAR; PG8_MMA(0, 0, At, B0); PG8_BAR; PG8_SCHED;
            PG8_LDA(At, 1, 1); PG8_STAGEB(PG8_SB(1, 0), b3); PG8_STAGEA(PG8_SA(1, 0), a3, 0, last);
            PG8_WAIT_V(6); PG8_WAIT_L(0); PG8_BAR; PG8_MMA(1, 0, At, B0); PG8_BAR; PG8_SCHED;
            }
        }
        if (wr == 0) PG8_BAR;
        { const int t3 = opaque_tid(wv) & 63; E(acc, cur, wr, wc, t3 & 15, t3 >> 4); }
        if (!has_next) break;
#pragma unroll
        for (int a = 0; a < 2; ++a)
#pragma unroll
            for (int b = 0; b < NBH; ++b)
#pragma unroll
                for (int m = 0; m < 4; ++m)
#pragma unroll
                    for (int n = 0; n < 2; ++n) acc[a][b][m][n] = (f32x4){0.f, 0.f, 0.f, 0.f};
        cur = nxt; cA = nA; cB = nB; ++ui;
        if constexpr (Epi::HAS_PRE) { const int t3 = opaque_tid(wv) & 63; E.pre(cur, wr, wc, t3 & 15, t3 >> 4); }
        if (wr == 1) PG8_BAR;
    }
    PG8_WAIT_V(0);
    PG8_BAR;
#undef PG8_SA
#undef PG8_SB
#undef PG8_STAGE2
#undef PG8_STAGEB
#undef PG8_STAGEA
#undef PG8_LDA
#undef PG8_LDB
#undef PG8_MMA
#undef PG8_WAIT_V
#undef PG8_WAIT_L
#undef PG8_BAR
#undef PG8_SCHED
}

struct DenseOrder {
    const char* A; const char* B; size_t tstepA, tstepB; int nM, nN, nwg, G, c;
    __device__ __forceinline__ void init(const void* A_, const void* B_, int Mr, int N, int lda, int ldb, int G_, int c_) {
        A = (const char*)A_; B = (const char*)B_; tstepA = (size_t)BM * lda * 2; tstepB = (size_t)BM * ldb * 2; nM = Mr / BM; nN = N / BM; nwg = nM * nN; G = G_; c = c_; }
    __device__ __forceinline__ bool next(int i, Unit& u) const {
        const long L = (long)i * G + c; if (L >= nwg) return false;
        int wgid = (int)L; { const int q = nwg / NXCD, r = nwg % NXCD, xcd = wgid % NXCD, off = wgid / NXCD; wgid = (xcd < r ? xcd * (q + 1) : r * (q + 1) + (xcd - r) * q) + off; }
        const int nig = WGM * nN, gid = wgid / nig, fm = gid * WGM, gsz = (nM - fm) < WGM ? (nM - fm) : WGM;
        u.pm = fm + ((wgid % nig) % gsz); u.pn = (wgid % nig) / gsz; u.x0 = 0; u.x1 = 0;
        u.A = A + (size_t)u.pm * tstepA; u.B = B + (size_t)u.pn * tstepB; return true;
    }
};
}

__device__ __forceinline__ float gelu_fast(float x) { const float u2 = -2.3022081984f * (x + 0.044715f * x * x * x); return x * __builtin_amdgcn_rcpf(1.f + __builtin_amdgcn_exp2f(u2)); }
__device__ __forceinline__ float sigm_fast(float x) { return __builtin_amdgcn_rcpf(1.f + __builtin_amdgcn_exp2f(-1.4426950408889634f * x)); }
__device__ __forceinline__ u32x4 pack8(const f32x4 a, const f32x4 b) { u32x4 w; w.x = pk2(a.x, a.y); w.y = pk2(a.z, a.w); w.z = pk2(b.x, b.y); w.w = pk2(b.z, b.w); return w; }
__device__ __forceinline__ void unpack8(const u32x4 w, f32x4& a, f32x4& b) { a = (f32x4){bflo(w.x), bfhi(w.x), bflo(w.y), bfhi(w.y)}; b = (f32x4){bflo(w.z), bfhi(w.z), bflo(w.w), bfhi(w.w)}; }

typedef const f32x4 (&AccRef)[2][2][4][2];
typedef const f32x4 (&AccRef1)[2][1][4][2];
struct EpiP1 {
    static constexpr bool PERM = true;
    static constexpr bool HAS_PRE = false;
    bf16 *UG, *GU, *GV, *QB, *GATES; const float* b_gate;
    __device__ __forceinline__ void operator()(AccRef acc, const pg8::Unit& u, int wr, int wc, int fr, int fq) const {
        asm volatile("" : "+v"(fr), "+v"(fq));
        const int pn = u.pn;
        f32x4 gb0[2], gb1[2];
#pragma unroll
        for (int bj = 0; bj < 2; ++bj) { const int c = ((pn >= 8) ? (pn - 8) * 256 : 0) + bj * 128 + wc * 32 + 8 * fq; gb0[bj] = *(const f32x4*)(b_gate + c); gb1[bj] = *(const f32x4*)(b_gate + c + 4); }
#pragma unroll
        for (int ai = 0; ai < 2; ++ai)
#pragma unroll
            for (int m = 0; m < 4; ++m) {
                const size_t row = (size_t)u.pm * 256 + ai * 128 + wr * 64 + m * 16 + fr;
#pragma unroll
                for (int bj = 0; bj < 2; ++bj) {
                    const int cl = bj * 128 + wc * 32 + 8 * fq;
                    f32x4 v0 = acc[ai][bj][m][0], v1 = acc[ai][bj][m][1];
                    if (pn < 2) { const int c = pn * 256 + cl; *(u32x4*)(UG + ((size_t)(c >> 4) * NCHK + (row >> 4)) * 512 + (row & 15) * 16 + (c & 15)) = pack8(v0, v1); }
                    else if (pn < 6) {
#pragma unroll
                        for (int j = 0; j < 4; ++j) { v0[j] = gelu_fast(v0[j]); v1[j] = gelu_fast(v1[j]); }
                        bf16* dst = (pn < 4) ? (GU + row * 512 + (pn - 2) * 256 + cl) : (GV + row * 512 + (pn - 4) * 256 + cl);
                        *(u32x4*)dst = pack8(v0, v1);
                    }
                    else if (pn < 8) { *(u32x4*)(QB + row * 512 + (pn - 6) * 256 + cl) = pack8(v0, v1); }
                    else {
                        const int c = (pn - 8) * 256 + cl;
#pragma unroll
                        for (int j = 0; j < 4; ++j) { v0[j] = sigm_fast(v0[j] + gb0[bj][j]); v1[j] = sigm_fast(v1[j] + gb1[bj][j]); }
                        *(u32x4*)(GATES + row * NGATE + c) = pack8(v0, v1);
                    }
                }
            }
    }
};
struct EpiKV {
    static constexpr bool PERM = true;
    static constexpr bool HAS_PRE = false;
    bf16 *KBl, *VTl;
    __device__ __forceinline__ void operator()(AccRef1 acc, const pg8::Unit& u, int wr, int wc, int fr, int fq) const {
        asm volatile("" : "+v"(fr), "+v"(fq));
#pragma unroll
        for (int ai = 0; ai < 2; ++ai)
#pragma unroll
            for (int m = 0; m < 4; ++m) {
                const int row = u.pm * 256 + ai * 128 + wr * 64 + m * 16 + fr, b = u.x0 * 2 + (row >> 8), mm = row & 255;
                const int c = u.pn * 128 + wc * 32 + 8 * fq;
                const f32x4 v0 = acc[ai][0][m][0], v1 = acc[ai][0][m][1];
                if (c < 512) { const int h = c >> 7, d = c & 127; *(u32x4*)(KBl + (((size_t)b * 4 + h) * 256 + mm) * 128 + d) = pack8(v0, v1); }
                else { const int cc = c - 512, h = cc >> 7, d = cc & 127; bf16* p = VTl + (((size_t)b * 4 + h) * 128 + d) * 256 + mm;
#pragma unroll
                    for (int j = 0; j < 4; ++j) { p[(size_t)j * 256] = (bf16)f2bf(v0[j]); p[(size_t)(4 + j) * 256] = (bf16)f2bf(v1[j]); } }
            }
    }
};
struct EpiGLU {
    static constexpr bool PERM = true;
    static constexpr bool HAS_PRE = false;
    const bf16* YS; bf16* YSSM; const float* b_glu;
    __device__ __forceinline__ void operator()(AccRef1 acc, const pg8::Unit& u, int wr, int wc, int fr, int fq) const {
        asm volatile("" : "+v"(fr), "+v"(fq));
        const int c0 = u.pn * 128 + wc * 32 + 8 * fq;
        const f32x4 b0 = *(const f32x4*)(b_glu + c0), b1 = *(const f32x4*)(b_glu + c0 + 4);
        u32x4 yv[2][4];
#pragma unroll
        for (int ai = 0; ai < 2; ++ai)
#pragma unroll
            for (int m = 0; m < 4; ++m) yv[ai][m] = *(const u32x4*)(YS + ((size_t)u.pm * 256 + ai * 128 + wr * 64 + m * 16 + fr) * 512 + c0);
        __builtin_amdgcn_sched_barrier(0);
#pragma unroll
        for (int ai = 0; ai < 2; ++ai)
#pragma unroll
            for (int m = 0; m < 4; ++m) {
                f32x4 v0 = acc[ai][0][m][0], v1 = acc[ai][0][m][1], y0, y1; unpack8(yv[ai][m], y0, y1);
#pragma unroll
                for (int j = 0; j < 4; ++j) { v0[j] = y0[j] * sigm_fast(v0[j] + b0[j]); v1[j] = y1[j] * sigm_fast(v1[j] + b1[j]); }
                *(u32x4*)(YSSM + ((size_t)u.pm * 256 + ai * 128 + wr * 64 + m * 16 + fr) * 512 + c0) = pack8(v0, v1);
            }
    }
};
struct GluOrder {
    const char* A; const char* B; int G, c;
    __device__ __forceinline__ bool next(int i, pg8::Unit& u) const {
        const int t = i * G + c; if (t >= 256) return false;
        const int x = t & 7, k = t >> 3; u.pm = x * 8 + (k >> 2); u.pn = k & 3; u.x0 = 0; u.x1 = 0;
        u.A = A + (size_t)u.pm * 256 * 512 * 2; u.B = B + (size_t)u.pn * 128 * 512 * 2; return true;
    }
};
struct MergeOrder {
    const char* Y0; const char* Y1; const char* Y2; const char* W; int G, c;
    __device__ __forceinline__ bool next(int i, pg8::Unit& u) const {
        const int ts = i / 3, bi = i - ts * 3, t = ts * G + c; if (t >= 512) return false;
        const int x = t & 7, k = t >> 3; u.pm = x * 8 + (k >> 3); u.pn = k & 7; u.x1 = bi; u.x0 = (bi == 2) ? 0 : bi + 1;
        u.A = ((u.x0 == 0) ? Y0 : (u.x0 == 1) ? Y1 : Y2) + (size_t)u.pm * 256 * 512 * 2; u.B = W + ((size_t)u.x0 * 1024 + (size_t)u.pn * 128) * 512 * 2; return true;
    }
};
struct EpiMergeF {
    static constexpr bool PERM = true;
    static constexpr bool HAS_PRE = true;
    const bf16* GATES; bf16* MERGED;
    f32x4 tot[2][4][2];
    u32x4 gv[2][4];
    __device__ __forceinline__ void pre(const pg8::Unit& u, int wr, int wc, int fr, int fq) {
        const int c = u.pn * 128 + wc * 32 + 8 * fq;
#pragma unroll
        for (int ai = 0; ai < 2; ++ai)
#pragma unroll
            for (int m = 0; m < 4; ++m) gv[ai][m] = *(const u32x4*)(GATES + ((size_t)u.pm * 256 + ai * 128 + wr * 64 + m * 16 + fr) * NGATE + u.x0 * D + c);
    }
    __device__ __forceinline__ void operator()(AccRef1 acc, const pg8::Unit& u, int wr, int wc, int fr, int fq) {
        asm volatile("" : "+v"(fr), "+v"(fq));
        const int c = u.pn * 128 + wc * 32 + 8 * fq, bi = u.x1;
#pragma unroll
        for (int ai = 0; ai < 2; ++ai)
#pragma unroll
            for (int m = 0; m < 4; ++m) {
                f32x4 g0, g1; unpack8(gv[ai][m], g0, g1);
                f32x4 v0 = acc[ai][0][m][0] * g0, v1 = acc[ai][0][m][1] * g1;
                if (bi != 0) { v0 = v0 + tot[ai][m][0]; v1 = v1 + tot[ai][m][1]; }
                if (bi == 2) *(u32x4*)(MERGED + ((size_t)u.pm * 256 + ai * 128 + wr * 64 + m * 16 + fr) * D + c) = pack8(v0, v1);
                else { tot[ai][m][0] = v0; tot[ai][m][1] = v1; }
            }
    }
};
struct EpiOut {
    static constexpr bool PERM = false;
    static constexpr bool HAS_PRE = false;
    const bf16* XB; bf16* Z1;
    __device__ __forceinline__ void operator()(AccRef acc, const pg8::Unit& u, int wr, int wc, int fr, int fq) const {
        asm volatile("" : "+v"(fr), "+v"(fq));
        const int c0 = u.pn * 256 + wc * 32 + 4 * fq;
#pragma unroll
        for (int ai = 0; ai < 2; ++ai)
#pragma unroll
            for (int mh = 0; mh < 2; ++mh) {
                u32x2 xv[2][2][2];
#pragma unroll
                for (int mm = 0; mm < 2; ++mm)
#pragma unroll
                    for (int bj = 0; bj < 2; ++bj)
#pragma unroll
                        for (int n = 0; n < 2; ++n) xv[mm][bj][n] = *(const u32x2*)(XB + ((size_t)u.pm * 256 + ai * 128 + wr * 64 + (mh * 2 + mm) * 16 + fr) * D + c0 + bj * 128 + 16 * n);
                __builtin_amdgcn_sched_barrier(0);
#pragma unroll
                for (int mm = 0; mm < 2; ++mm)
#pragma unroll
                    for (int bj = 0; bj < 2; ++bj)
#pragma unroll
                        for (int n = 0; n < 2; ++n) { const int m = mh * 2 + mm;
                            const f32x4 z = (f32x4){bflo(xv[mm][bj][n].x), bfhi(xv[mm][bj][n].x), bflo(xv[mm][bj][n].y), bfhi(xv[mm][bj][n].y)} * ALPHA + acc[ai][bj][m][n];
                            u32x2 zw; zw.x = pk2(z.x, z.y); zw.y = pk2(z.z, z.w);
                            *(u32x2*)(Z1 + ((size_t)u.pm * 256 + ai * 128 + wr * 64 + m * 16 + fr) * D + c0 + bj * 128 + 16 * n) = zw; }
            }
    }
};
struct S5Order { const char* A; const char* B; size_t bstep; int G, c;
    __device__ __forceinline__ bool next(int i, pg8::Unit& u) const { const int L = i * G + c; if (L >= 128) return false;
        u.x0 = (L & 7) * 4 + (L >> 5); u.pm = (L >> 3) & 3; u.pn = 0; u.x1 = 0;        u.A = A + ((size_t)u.x0 * NCHK + (size_t)u.pm * 256) * 1024; u.B = B + (size_t)u.x0 * bstep; return true; } };
struct EpiS5St {
    static constexpr bool PERM = false;
    static constexpr bool HAS_PRE = false;
    float* SST;
    __device__ __forceinline__ void operator()(AccRef acc, const pg8::Unit& u, int wr, int wc, int fr, int fq) const {
        asm volatile("" : "+v"(fr), "+v"(fq));
#pragma unroll
        for (int ai = 0; ai < 2; ++ai)
#pragma unroll
            for (int m = 0; m < 4; ++m) {
                const size_t chunk = (size_t)u.pm * 256 + ai * 128 + wr * 64 + m * 16 + fr;
                float* rowp = SST + ((size_t)u.x0 * NCHK + chunk) * 256;
#pragma unroll
                for (int bj = 0; bj < 2; ++bj)
#pragma unroll
                    for (int n = 0; n < 2; ++n) *(f32x4*)(rowp + bj * 128 + wc * 32 + 16 * n + 4 * fq) = acc[ai][bj][m][n];
            }
    }
};
struct EpiS5Out {
    static constexpr bool PERM = true;
    static constexpr bool HAS_PRE = false;
    bf16* YS;
    __device__ __forceinline__ void operator()(AccRef acc, const pg8::Unit& u, int wr, int wc, int fr, int fq) const {
        asm volatile("" : "+v"(fr), "+v"(fq));
#pragma unroll
        for (int ai = 0; ai < 2; ++ai)
#pragma unroll
            for (int m = 0; m < 4; ++m) {
                const size_t chunk = (size_t)u.pm * 256 + ai * 128 + wr * 64 + m * 16 + fr;
#pragma unroll
                for (int bj = 0; bj < 2; ++bj) {
                    const int n0 = bj * 128 + wc * 32 + 8 * fq, s = n0 >> 4, h0 = n0 & 15;
                    f32x4 v0 = acc[ai][bj][m][0], v1 = acc[ai][bj][m][1];
#pragma unroll
                    for (int j = 0; j < 4; ++j) { v0[j] = gelu_fast(v0[j]); v1[j] = gelu_fast(v1[j]); }
                    *(u32x4*)(YS + (chunk * 16 + s) * 512 + u.x0 * 16 + h0) = pack8(v0, v1);
                }
            }
    }
};
struct MoeTab { int tb[33]; int sb[33]; int cn[32]; };
__device__ __forceinline__ int moe_ntile_x(const LAS MoeTab* T, int x, int NX) {
    int n = 0;
#pragma unroll 1
    for (int e = x; e < NEXP; e += NX) n += __builtin_amdgcn_readfirstlane(T->tb[e + 1]) - __builtin_amdgcn_readfirstlane(T->tb[e]);
    return n;
}
__device__ __forceinline__ void moe_local_tile(const LAS MoeTab* T, int x, int NX, int lt, int& e_out, int& pm_out) {
    int e = x;
#pragma unroll 1
    for (; e + NX < NEXP; e += NX) { const int n = __builtin_amdgcn_readfirstlane(T->tb[e + 1]) - __builtin_amdgcn_readfirstlane(T->tb[e]); if (lt < n) break; lt -= n; }
    e_out = e; pm_out = lt;
}
struct MoeOrderGU {
    const char* X1Bp; const char* WGU; const int* LIST; int e, pm, cnt, pn;
    __device__ __forceinline__ bool next(int i, pg8::Unit& u) const {
        if (i >= 1) return false;
        u.pm = pm; u.pn = pn; u.x0 = e; u.x1 = cnt;
        u.A = X1Bp; u.B = WGU + ((size_t)e * 512 + (size_t)pn * 256) * (D * 2); return true;
    }
    __device__ __forceinline__ unsigned row_off(const pg8::Unit& u, int r) const {
        const int rr = u.pm * 256 + r; const int tok = (rr < u.x1) ? (LIST[(size_t)u.x0 * LCAP + rr] >> 1) : 0;
        return (unsigned)tok * (unsigned)(D * 2);
    }
};
struct EpiMoeGU {
    static constexpr bool PERM = true;
    static constexpr bool HAS_PRE = false;
    const LAS MoeTab* T; const int* LIST; const float* TOKW; bf16* HB;
    float w[2][4];
    __device__ __forceinline__ void init(int e, int pm, int cnt, int tid) {
        const int wr = tid >> 8, fr = tid & 15; int pr[2][4];
#pragma unroll
        for (int ai = 0; ai < 2; ++ai)
#pragma unroll
            for (int m = 0; m < 4; ++m) { const int rr = pm * 256 + ai * 128 + wr * 64 + m * 16 + fr; pr[ai][m] = (rr < cnt) ? LIST[(size_t)e * LCAP + rr] : 0; }
#pragma unroll
        for (int ai = 0; ai < 2; ++ai)
#pragma unroll
            for (int m = 0; m < 4; ++m) w[ai][m] = TOKW[pr[ai][m]];
    }
    __device__ __forceinline__ void operator()(AccRef acc, const pg8::Unit& u, int wr, int wc, int fr, int fq) {
        asm volatile("" : "+v"(fr), "+v"(fq));
        const int e = u.x0, cnt = u.x1, sb = __builtin_amdgcn_readfirstlane(T->sb[e]);
#pragma unroll
        for (int ai = 0; ai < 2; ++ai)
#pragma unroll
            for (int m = 0; m < 4; ++m) {
                const int rr = u.pm * 256 + ai * 128 + wr * 64 + m * 16 + fr;
                if (rr < cnt) {
                    const int f = u.pn * 128 + wc * 32 + 8 * fq;
                    f32x4 g0 = acc[ai][0][m][0], g1 = acc[ai][0][m][1]; const f32x4 u0 = acc[ai][1][m][0], u1 = acc[ai][1][m][1];
#pragma unroll
                    for (int j = 0; j < 4; ++j) { g0[j] = g0[j] * sigm_fast(g0[j]) * u0[j] * w[ai][m]; g1[j] = g1[j] * sigm_fast(g1[j]) * u1[j] * w[ai][m]; }
                    *(u32x4*)(HB + ((size_t)sb + rr) * DEXP + f) = pack8(g0, g1);
                }
            }
    }
};
struct MoeOrderD {
    const LAS MoeTab* T; const char* HBp; const char* WD; int x, NX, d0, ds, d1;
    __device__ __forceinline__ bool next(int i, pg8::Unit& u) const {
        const int du = d0 + i * ds; if (du >= d1) return false;
        int e, pm; moe_local_tile(T, x, NX, du >> 2, e, pm);
        u.pm = pm; u.pn = du & 3; u.x0 = e; u.x1 = __builtin_amdgcn_readfirstlane(T->cn[e]);
        u.A = HBp + ((size_t)__builtin_amdgcn_readfirstlane(T->sb[e]) + (size_t)pm * 256) * (DEXP * 2); u.B = WD + ((size_t)e * D + (size_t)u.pn * 256) * (DEXP * 2); return true;
    }
};
struct EpiMoeD {
    static constexpr bool PERM = true;
    static constexpr bool HAS_PRE = true;
    const int* LIST; bf16* O2;
    int pr[2][4];
    __device__ __forceinline__ void pre(const pg8::Unit& u, int wr, int wc, int fr, int fq) {
#pragma unroll
        for (int ai = 0; ai < 2; ++ai)
#pragma unroll
            for (int m = 0; m < 4; ++m) { const int rr = u.pm * 256 + ai * 128 + wr * 64 + m * 16 + fr; pr[ai][m] = (rr < u.x1) ? LIST[(size_t)u.x0 * LCAP + rr] : 0; }
    }
    __device__ __forceinline__ void operator()(AccRef acc, const pg8::Unit& u, int wr, int wc, int fr, int fq) {
        asm volatile("" : "+v"(fr), "+v"(fq));
        const int cnt = u.x1;
#pragma unroll
        for (int ai = 0; ai < 2; ++ai)
#pragma unroll
            for (int m = 0; m < 4; ++m) {
                const int rr = u.pm * 256 + ai * 128 + wr * 64 + m * 16 + fr;
                if (rr < cnt) {
#pragma unroll
                    for (int bj = 0; bj < 2; ++bj) {
                        const int c = u.pn * 256 + bj * 128 + wc * 32 + 8 * fq;
                        *(u32x4*)(O2 + (size_t)pr[ai][m] * D + c) = pack8(acc[ai][bj][m][0], acc[ai][bj][m][1]);
                    }
                }
            }
    }
};

typedef __attribute__((address_space(4))) const unsigned char* kaptr_t;
__device__ __forceinline__ kaptr_t ka_base() { kaptr_t p = (kaptr_t)__builtin_amdgcn_kernarg_segment_ptr(); asm volatile("" : "+s"(p)); return p; }
#define KIN(k) (*(const float* const __attribute__((address_space(4)))*)(ka + 8 * (k)))

typedef float f32x16 __attribute__((ext_vector_type(16)));
typedef short s16x8 __attribute__((ext_vector_type(8)));
constexpr int AT_KSTR = 272, AT_VSTR = 520, AT_VOFF = 256 * AT_KSTR;
__device__ __forceinline__ void attn_phase(LAS unsigned char* lds, const int wv, const bf16* QB, const bf16* KBl, const bf16* VTl, bf16* YMEM, const int G, const int bid) {
    const int tid = opaque_tid(wv), lane = tid & 63, r = lane & 31, hh = lane >> 5;
    for (int u = bid; u < 256; u += G) {
        const int panel = (u & 7) * 8 + (u >> 5), hd = (u >> 3) & 3, b = panel >> 5, tile = panel & 31;
        const bf16* kg = KBl + ((size_t)b * 4 + hd) * 256 * 128; const bf16* vg = VTl + ((size_t)b * 4 + hd) * 128 * 256;
        const size_t tok = (size_t)b * SEQ + (size_t)tile * 256 + wv * 32 + r;
        s16x8 qf[8];
#pragma unroll
        for (int ks = 0; ks < 8; ++ks) qf[ks] = *(const s16x8*)(QB + tok * 512 + hd * 128 + 16 * ks + 8 * hh);
        __syncthreads();
        {
            u32x4 kw[8], vw[8];
            const int rot = (u >> 3) * 128;
#pragma unroll
            for (int k = 0; k < 8; ++k) { const int i = (tid + k * NT + rot) & 4095; kw[k] = *(const u32x4*)(kg + (size_t)i * 8); vw[k] = *(const u32x4*)(vg + (size_t)i * 8); }
#pragma unroll
            for (int k = 0; k < 8; ++k) { const int i = (tid + k * NT + rot) & 4095; *(LAS u32x4*)(lds + (i >> 4) * AT_KSTR + (i & 15) * 16) = kw[k]; }
#pragma unroll
            for (int k = 0; k < 8; ++k) { const int i = (tid + k * NT + rot) & 4095; LAS u32x2* d = (LAS u32x2*)(lds + AT_VOFF + (i >> 5) * AT_VSTR + (i & 31) * 16); d[0] = (u32x2){vw[k].x, vw[k].y}; d[1] = (u32x2){vw[k].z, vw[k].w}; }
        }
        __syncthreads();
        f32x16 acc[8];
#pragma unroll
        for (int mt = 0; mt < 8; ++mt)
#pragma unroll
            for (int i = 0; i < 16; ++i) acc[mt][i] = 0.f;
#pragma unroll
        for (int ks = 0; ks < 8; ++ks) {
            s16x8 a[8];
#pragma unroll
            for (int mt = 0; mt < 8; ++mt) a[mt] = *(const LAS s16x8*)(lds + (32 * mt + r) * AT_KSTR + (16 * ks + 8 * hh) * 2);
#pragma unroll
            for (int mt = 0; mt < 8; ++mt) acc[mt] = __builtin_amdgcn_mfma_f32_32x32x16_bf16(a[mt], qf[ks], acc[mt], 0, 0, 0);
        }
        float mx = -3.0e38f;
#pragma unroll
        for (int mt = 0; mt < 8; ++mt)
#pragma unroll
            for (int i = 0; i < 16; ++i) mx = fmaxf(mx, acc[mt][i]);
        mx = fmaxf(mx, lane_xor(mx, lane, 32));
        const float C2 = 0.08838834764831845f * 1.4426950408889634f;
        float sum = 0.f;
#pragma unroll
        for (int mt = 0; mt < 8; ++mt)
#pragma unroll
            for (int i = 0; i < 16; ++i) { const float p = __builtin_amdgcn_exp2f((acc[mt][i] - mx) * C2); acc[mt][i] = p; sum += p; }
        sum += lane_xor(sum, lane, 32);
        const float inv = 1.f / sum;
        __syncthreads();
        f32x16 o[4];
#pragma unroll
        for (int dt = 0; dt < 4; ++dt)
#pragma unroll
            for (int i = 0; i < 16; ++i) o[dt][i] = 0.f;
#pragma unroll
        for (int mt = 0; mt < 8; ++mt)
#pragma unroll
            for (int s = 0; s < 2; ++s) {
                u32x4 pw; pw.x = pk2(acc[mt][8 * s + 0], acc[mt][8 * s + 1]); pw.y = pk2(acc[mt][8 * s + 2], acc[mt][8 * s + 3]);
                pw.z = pk2(acc[mt][8 * s + 4], acc[mt][8 * s + 5]); pw.w = pk2(acc[mt][8 * s + 6], acc[mt][8 * s + 7]);
                const s16x8 pb = __builtin_bit_cast(s16x8, pw);
#pragma unroll
                for (int dt = 0; dt < 4; ++dt) {
                    const LAS unsigned char* base = lds + AT_VOFF + (32 * dt + r) * AT_VSTR + (32 * mt + 16 * s + 4 * hh) * 2;
                    const u32x2 lo = *(const LAS u32x2*)base, hi = *(const LAS u32x2*)(base + 16);
                    const u32x4 aw = (u32x4){lo.x, lo.y, hi.x, hi.y};
                    o[dt] = __builtin_amdgcn_mfma_f32_32x32x16_bf16(__builtin_bit_cast(s16x8, aw), pb, o[dt], 0, 0, 0);
                }
            }
        LAS unsigned char* ob = lds + wv * (32 * 264);
#pragma unroll
        for (int dt = 0; dt < 4; ++dt)
#pragma unroll
            for (int g4 = 0; g4 < 4; ++g4) {
                u32x2 w; w.x = pk2(o[dt][4 * g4] * inv, o[dt][4 * g4 + 1] * inv); w.y = pk2(o[dt][4 * g4 + 2] * inv, o[dt][4 * g4 + 3] * inv);
                *(LAS u32x2*)(ob + r * 264 + (32 * dt + 8 * g4 + 4 * hh) * 2) = w;
            }
        asm volatile("s_waitcnt lgkmcnt(0)" ::: "memory");
        const size_t tok0 = (size_t)b * SEQ + (size_t)tile * 256 + wv * 32;
#pragma unroll
        for (int k = 0; k < 8; ++k) {
            const int p = lane + 64 * k, t = p >> 4, c16 = p & 15;
            const u32x2 lo = *(const LAS u32x2*)(ob + t * 264 + c16 * 16), hi = *(const LAS u32x2*)(ob + t * 264 + c16 * 16 + 8);
            *(u32x4*)(YMEM + (tok0 + t) * 512 + hd * 128 + c16 * 8) = (u32x4){lo.x, lo.y, hi.x, hi.y};
        }
    }
    __syncthreads();
}

constexpr int GM_STR = 272;
__device__ __forceinline__ void gmlp_phase(LAS unsigned char* lds, const int wv, const bf16* GU, const bf16* GV, const bf16* WSP, const float* b_sp, const float* gln_g, const float* gln_b,
                                           bf16* YGMLP, const int G, const int bid) {
    const int tid = opaque_tid(wv), lane = tid & 63, r = lane & 31, hh = lane >> 5;
    for (int u0 = (bid + G / 2) % G; u0 < 128; u0 += G) {
        const int u = (G == 256) ? ((u0 & 7) * 16 + (u0 >> 3)) : u0;
        const size_t t0 = (size_t)u * CHUNK;
        const int g = wv;
        const unsigned woff = (unsigned)(r * CHUNK + 8 * hh), uoff = (unsigned)((lane >> 3) * 512 + (lane & 7) * 8);
        __syncthreads();
        s16x8 bw1[8][2];
#pragma unroll
        for (int ks = 0; ks < 8; ++ks)
#pragma unroll
            for (int n2 = 0; n2 < 2; ++n2) bw1[ks][n2] = *(const s16x8*)(WSP + (size_t)(g * CHUNK + 32 * n2) * CHUNK + 16 * ks + woff);
        float gam[8], bet[8];
#pragma unroll
        for (int e = 0; e < 8; ++e) { gam[e] = gln_g[lane + 64 * e]; bet[e] = gln_b[lane + 64 * e]; }
        for (int jb = 0; jb < 4; ++jb) {
            const int j0 = wv * 16 + jb * 4;
            float v[4][8]; float s[4], q[4];
#pragma unroll
            for (int k = 0; k < 4; ++k)
#pragma unroll
                for (int e = 0; e < 8; ++e) v[k][e] = bf2f(GV[(t0 + j0 + k) * 512 + lane + 64 * e]);
#pragma unroll
            for (int k = 0; k < 4; ++k) { s[k] = 0.f;
#pragma unroll
                for (int e = 0; e < 8; ++e) s[k] += v[k][e]; }
#pragma unroll
            for (int k = 0; k < 4; ++k) s[k] = wave_sum(s[k], lane) * (1.f / 512.f);
#pragma unroll
            for (int k = 0; k < 4; ++k) { q[k] = 0.f;
#pragma unroll
                for (int e = 0; e < 8; ++e) { v[k][e] -= s[k]; q[k] += v[k][e] * v[k][e]; } }
#pragma unroll
            for (int k = 0; k < 4; ++k) q[k] = rsqrtf(wave_sum(q[k], lane) * (1.f / 512.f) + LN_EPS);
#pragma unroll
            for (int k = 0; k < 4; k += 2)
#pragma unroll
                for (int e = 0; e < 8; ++e)
                    *(LAS unsigned*)(lds + (lane + 64 * e) * GM_STR + (j0 + k) * 2) = pk2(v[k][e] * q[k] * gam[e] + bet[e], v[k + 1][e] * q[k + 1] * gam[e] + bet[e]);
        }
        __syncthreads();
        s16x8 bw2[8][2];
#pragma unroll
        for (int ks = 0; ks < 8; ++ks)
#pragma unroll
            for (int n2 = 0; n2 < 2; ++n2) bw2[ks][n2] = *(const s16x8*)(WSP + (size_t)(g * CHUNK + 64 + 32 * n2) * CHUNK + 16 * ks + woff);
        f32x16 acc[2][4];
#pragma unroll
        for (int mt = 0; mt < 2; ++mt)
#pragma unroll
            for (int nt = 0; nt < 2; ++nt)
#pragma unroll
                for (int i = 0; i < 16; ++i) acc[mt][nt][i] = 0.f;
#pragma unroll
        for (int ks = 0; ks < 8; ++ks) {
            s16x8 a[2];
#pragma unroll
            for (int mt = 0; mt < 2; ++mt) a[mt] = *(const LAS s16x8*)(lds + (g * 64 + 32 * mt + r) * GM_STR + (16 * ks + 8 * hh) * 2);
#pragma unroll
            for (int mt = 0; mt < 2; ++mt)
#pragma unroll
                for (int n2 = 0; n2 < 2; ++n2) acc[mt][n2] = __builtin_amdgcn_mfma_f32_32x32x16_bf16(a[mt], bw1[ks][n2], acc[mt][n2], 0, 0, 0);
        }
        __builtin_amdgcn_sched_barrier(0);
#pragma unroll
        for (int mt = 0; mt < 2; ++mt)
#pragma unroll
            for (int nt = 2; nt < 4; ++nt)
#pragma unroll
                for (int i = 0; i < 16; ++i) acc[mt][nt][i] = 0.f;
#pragma unroll
        for (int ks = 0; ks < 8; ++ks) {
            s16x8 a[2];
#pragma unroll
            for (int mt = 0; mt < 2; ++mt) a[mt] = *(const LAS s16x8*)(lds + (g * 64 + 32 * mt + r) * GM_STR + (16 * ks + 8 * hh) * 2);
#pragma unroll
            for (int mt = 0; mt < 2; ++mt)
#pragma unroll
                for (int n2 = 0; n2 < 2; ++n2) acc[mt][2 + n2] = __builtin_amdgcn_mfma_f32_32x32x16_bf16(a[mt], bw2[ks][n2], acc[mt][2 + n2], 0, 0, 0);
        }
        LAS unsigned char* sl = lds + (g * 64) * GM_STR;
        asm volatile("s_waitcnt lgkmcnt(0)" ::: "memory");
#pragma unroll
        for (int nt = 0; nt < 4; ++nt) {
            const int i = 32 * nt + r; const float bias = b_sp[g * CHUNK + i];
#pragma unroll
            for (int mt = 0; mt < 2; ++mt)
#pragma unroll
                for (int g4 = 0; g4 < 4; ++g4) {
                    u32x2 w; w.x = pk2(acc[mt][nt][4 * g4] + bias, acc[mt][nt][4 * g4 + 1] + bias); w.y = pk2(acc[mt][nt][4 * g4 + 2] + bias, acc[mt][nt][4 * g4 + 3] + bias);
                    *(LAS u32x2*)(sl + i * 136 + (32 * mt + 8 * g4 + 4 * hh) * 2) = w;
                }
        }
        asm volatile("s_waitcnt lgkmcnt(0)" ::: "memory");
        u32x4 uu[16];
#pragma unroll
        for (int k = 0; k < 16; ++k) uu[k] = *(const u32x4*)(GU + (t0 + 8 * k) * 512 + g * 64 + uoff);
#pragma unroll
        for (int k = 0; k < 16; ++k) {
            const int p = lane + 64 * k, pos = p >> 3, c8 = p & 7;
            const u32x2 lo = *(const LAS u32x2*)(sl + pos * 136 + c8 * 16), hi = *(const LAS u32x2*)(sl + pos * 136 + c8 * 16 + 8);
            u32x4 w;
            w.x = pk2(bflo(uu[k].x) * bflo(lo.x), bfhi(uu[k].x) * bfhi(lo.x)); w.y = pk2(bflo(uu[k].y) * bflo(lo.y), bfhi(uu[k].y) * bfhi(lo.y));
            w.z = pk2(bflo(uu[k].z) * bflo(hi.x), bfhi(uu[k].z) * bfhi(hi.x)); w.w = pk2(bflo(uu[k].w) * bflo(hi.y), bfhi(uu[k].w) * bfhi(hi.y));
            *(u32x4*)(YGMLP + (t0 + 8 * k) * 512 + g * 64 + uoff) = w;
        }
    }
    __syncthreads();
}

__device__ __forceinline__ void transpose_item(const float* W, int ldw, int k0, int n0, bf16* WT, int ldt, int drow0, LAS float* scr, int lane) {
    const int kr = lane >> 3, n4 = (lane & 7) * 4;
    f32x4 v[8];
#pragma unroll
    for (int i = 0; i < 8; ++i) v[i] = *(const f32x4*)(W + (size_t)(k0 + 8 * i + kr) * ldw + n0 + n4);
#pragma unroll
    for (int i = 0; i < 8; ++i) { LAS float* d = scr + (8 * i + kr) * 33 + n4; d[0] = v[i].x; d[1] = v[i].y; d[2] = v[i].z; d[3] = v[i].w; }
    asm volatile("s_waitcnt lgkmcnt(0)" ::: "memory");
    const int c = lane & 7;
#pragma unroll
    for (int j = 0; j < 4; ++j) { const int n = (lane >> 3) + 8 * j; const LAS float* s = scr + (8 * c) * 33 + n;
        u32x4 o; o.x = pk2(s[0 * 33], s[1 * 33]); o.y = pk2(s[2 * 33], s[3 * 33]); o.z = pk2(s[4 * 33], s[5 * 33]); o.w = pk2(s[6 * 33], s[7 * 33]);
        *(u32x4*)(WT + (size_t)(drow0 + n) * ldt + k0 + 8 * c) = o; }
    asm volatile("s_waitcnt lgkmcnt(0)" ::: "memory");
}
constexpr size_t WE_CAT = 0;
constexpr size_t WE_GLU = WE_CAT + (size_t)5120 * 1024;
constexpr size_t WE_BR = WE_GLU + (size_t)512 * 512;
constexpr size_t WE_OUT = WE_BR + (size_t)3 * 1024 * 512;
constexpr size_t WE_SP = WE_OUT + (size_t)1024 * 1024;
constexpr size_t WL_GU = 0;
constexpr size_t WL_D = WL_GU + (size_t)32 * 512 * 1024;
constexpr int CV_IN = 16 * 64, CV_GATE = 16 * 96, CV_GLU = 8 * 16, CV_BR = 8 * 32, CV_OUT = 16 * 32, CV_EG = 16 * 8, CV_ED = 4 * 32;
constexpr int CV_EARLY = CV_IN + CV_GATE + CV_GLU + 3 * CV_BR + CV_OUT, CV_LATE = 32 * CV_EG * 2 + 32 * CV_ED;
__device__ __forceinline__ void convert_early_item(const kaptr_t ka, int l, bf16* WE, int it, LAS float* scr, int lane) {
    int r = it;
    if (r < CV_IN) { transpose_item(KIN(2) + (size_t)l * D * INW, INW, (r / 64) * 64, (r % 64) * 32, WE + WE_CAT, D, (r % 64) * 32, scr, lane); return; } r -= CV_IN;
    if (r < CV_GATE) { transpose_item(KIN(3) + (size_t)l * D * NGATE, NGATE, (r / 96) * 64, (r % 96) * 32, WE + WE_CAT, D, 2048 + (r % 96) * 32, scr, lane); return; } r -= CV_GATE;
    if (r < CV_GLU) { transpose_item(KIN(13) + (size_t)l * 512 * 512, 512, (r / 16) * 64, (r % 16) * 32, WE + WE_GLU, 512, (r % 16) * 32, scr, lane); return; } r -= CV_GLU;
    if (r < 3 * CV_BR) { const int b = r / CV_BR, q = r % CV_BR; transpose_item(KIN(20) + ((size_t)l * 3 + b) * 512 * D, D, (q / 32) * 64, (q % 32) * 32, WE + WE_BR + (size_t)b * 1024 * 512, 512, (q % 32) * 32, scr, lane); return; } r -= 3 * CV_BR;
    transpose_item(KIN(21) + (size_t)l * D * D, D, (r / 32) * 64, (r % 32) * 32, WE + WE_OUT, D, (r % 32) * 32, scr, lane);
}
__device__ __forceinline__ void convert_late_item(const kaptr_t ka, int l, bf16* WL, int it, LAS float* scr, int lane) {
    int r = it;
    if (r < 64 * CV_EG) { const int sel = r / (32 * CV_EG), q0 = r % (32 * CV_EG), e = q0 / CV_EG, q = q0 % CV_EG; const int n0 = (q % 8) * 32;
        transpose_item(KIN(28 + sel) + ((size_t)l * 32 + e) * D * DEXP, DEXP, (q / 8) * 64, n0, WL + WL_GU + (size_t)e * 512 * 1024, D, (n0 >> 7) * 256 + sel * 128 + (n0 & 127), scr, lane); return; } r -= 64 * CV_EG;
    { const int e = r / CV_ED, q = r % CV_ED; transpose_item(KIN(30) + ((size_t)l * 32 + e) * DEXP * D, D, (q / 32) * 64, (q % 32) * 32, WL + WL_D + (size_t)e * 1024 * 256, DEXP, (q % 32) * 32, scr, lane); }
}
__device__ __forceinline__ void convert_early_share(const kaptr_t ka, int l, bf16* WE, int it0, int step, LAS float* scr, int lane) {
    for (int it = it0; it < CV_EARLY; it += step) convert_early_item(ka, l, WE, it, scr, lane);
    const f32x4* wsp = (const f32x4*)(KIN(17) + (size_t)l * GG * CHUNK * CHUNK);
    for (int i = it0 * 64 + lane; i < GG * CHUNK * CHUNK / 4; i += step * 64) { const f32x4 v = wsp[i]; u32x2 w; w.x = pk2(v.x, v.y); w.y = pk2(v.z, v.w); ((u32x2*)(WE + WE_SP))[i] = w; }
}
#define PHASE_IDS() const int tid = opaque_tid(wv), lane = tid & 63, wave = __builtin_amdgcn_readfirstlane(tid >> 6); (void)lane; (void)wave
#define PHASE_PTRS() \
    int bid_l = bid; asm volatile("" : "+s"(bid_l)); (void)bid_l; \
    const kaptr_t ka = ka_base(); unsigned char* ws = *(unsigned char* const __attribute__((address_space(4)))*)(ka + 272); \
    unsigned* ctl = (unsigned*)(ws + WS_CTL); float* X32 = (float*)(ws + WS_X32); bf16* XB = (bf16*)(ws + WS_XB); \
    float* Z1 = (float*)(ws + WS_Z1); bf16* X1B = (bf16*)(ws + WS_X1B); \
    bf16* UG = (bf16*)(ws + WS_AEXT); bf16* GU = (bf16*)(ws + WS_GU); bf16* GV = (bf16*)(ws + WS_GV); bf16* QB = (bf16*)(ws + WS_Q); \
    bf16* GATES = (bf16*)(ws + WS_GATES); \
    bf16* YS = (bf16*)(ws + WS_YS); bf16* YSSM = (bf16*)(ws + WS_YSSM); bf16* YGMLP = (bf16*)(ws + WS_YGMLP); bf16* YMEM = (bf16*)(ws + WS_YMEM); \
    bf16* MERGED = (bf16*)(ws + WS_MERGED); bf16* T0 = (bf16*)(ws + WS_T0); bf16* T1 = (bf16*)(ws + WS_T1); \
    bf16* KB = (bf16*)(ws + WS_KB); bf16* VT = (bf16*)(ws + WS_VT); \
    bf16* HB = (bf16*)(ws + WS_HB); int* LIST = (int*)(ws + WS_LIST); float* TOKW = (float*)(ws + WS_TOKW); \
    bf16* O2 = (bf16*)(ws + WS_O2); bf16* WBL = (bf16*)(ws + WS_WBL); (void)WBL; float* S5TAB = (float*)(ws + WS_S5TAB); (void)S5TAB; \
    bf16* WKVT = (bf16*)(ws + WS_GATES); bf16* MEMB = (bf16*)(ws + WS_GATES + 8 * MiB); \
    float* SST = (float*)(ws + WS_SST); bf16* S5E = (bf16*)(ws + WS_S5E); bf16* S5BT = (bf16*)(ws + WS_S5BT); float* PTAB = (float*)(ws + WS_PTAB); float* KTAB = (float*)(ws + WS_KTAB); \
    (void)SST; (void)S5E; (void)S5BT; (void)PTAB; (void)KTAB; \
    (void)ctl; (void)X32; (void)XB; (void)Z1; (void)X1B; (void)UG; (void)GU; (void)GV; (void)QB; (void)GATES; (void)YS; (void)YSSM; (void)YGMLP; (void)YMEM; \
    (void)MERGED; (void)T0; (void)T1; (void)KB; (void)VT; (void)HB; (void)LIST; (void)TOKW; (void)O2; (void)WKVT; (void)MEMB
#define PHASE_LPTRS() \
    int l = l_iter; asm volatile("" : "+s"(l)); \
    bf16* WBE = (bf16*)(ws + ((l & 1) ? WS_WBE1 : WS_WBE0)); (void)WBE; \
    const float* b_gate = KIN(4) + (size_t)l * NGATE; \
    const float* lam_re = KIN(5) + (size_t)l * 2 * SG * SP; const float* lam_im = KIN(6) + (size_t)l * 2 * SG * SP; \
    const float* log_step = KIN(7) + (size_t)l * 2 * SG; \
    const float* sb_re = KIN(8) + (size_t)l * SG * SP * SGC; const float* sb_im = KIN(9) + (size_t)l * SG * SP * SGC; \
    const float* sc_re = KIN(10) + (size_t)l * SG * SGC * SP; const float* sc_im = KIN(11) + (size_t)l * SG * SGC * SP; \
    const float* ssm_d = KIN(12) + (size_t)l * SSMW; const float* b_glu = KIN(14) + (size_t)l * SSMW; \
    const float* gln_g = KIN(15) + (size_t)l * GW; const float* gln_b = KIN(16) + (size_t)l * GW; \
    const float* w_sp = KIN(17) + (size_t)l * GG * CHUNK * CHUNK; const float* b_sp = KIN(18) + (size_t)l * GG * CHUNK; \
    const float* ln1_g = KIN(22) + (size_t)l * D; const float* ln1_b = KIN(23) + (size_t)l * D; \
    const float* w_rg = KIN(24) + (size_t)l * D * NGRP; const float* b_rg = KIN(25) + (size_t)l * NGRP; \
    const float* w_re = KIN(26) + (size_t)l * NGRP * D * EPG; const float* b_re = KIN(27) + (size_t)l * NGRP * EPG; \
    const float* ln2_g = KIN(31) + (size_t)l * D; const float* ln2_b = KIN(32) + (size_t)l * D; \
    (void)b_gate; (void)lam_re; (void)lam_im; (void)log_step; (void)sb_re; (void)sb_im; (void)sc_re; (void)sc_im; (void)ssm_d; (void)b_glu; (void)gln_g; (void)gln_b; \
    (void)w_sp; (void)b_sp; (void)ln1_g; (void)ln1_b; (void)w_rg; (void)b_rg; (void)w_re; (void)b_re; (void)ln2_g; (void)ln2_b
struct Args { const float* in[33]; float* out; unsigned char* ws; };

__global__ void __launch_bounds__(NT, 2) fwd_kernel(Args args) {
    extern __shared__ __attribute__((aligned(16))) unsigned char lds_raw[];
    float* smf = (float*)lds_raw;
    LAS unsigned char* lds = (LAS unsigned char*)lds_raw;
    const int G = gridDim.x, bid = blockIdx.x;
    const int wv = __builtin_amdgcn_readfirstlane((int)threadIdx.x >> 6);
    if (threadIdx.x < 64) ((LAS unsigned*)(lds + LDS_MISC))[threadIdx.x] = 0u;
    __syncthreads();
    XcdBarrier bar = xcd_barrier_post((unsigned*)(args.ws + WS_CTL) + CW_BAR, (volatile LAS unsigned*)(lds + LDS_MISC));
#define GRID_BAR() do { const int t_ = opaque_tid(wv); xcd_barrier(bar, t_ == 0); } while (0)
    LAS MoeTab* mtab = (LAS MoeTab*)(lds + LDS_MISC + 256);
    const int NGW = G * 8;

    {
        PHASE_IDS(); PHASE_PTRS(); const int gw = bid * 8 + wave; LAS float* cscr = (LAS float*)(lds + wave * 16384);
        const float* x_in = KIN(0); const float* mem = KIN(1);
        const size_t n4 = (size_t)M * D / 4;
        for (size_t i0 = (size_t)bid * NT + tid; i0 < n4; i0 += (size_t)G * NT * 8) {
            f32x4 v[8];
#pragma unroll
            for (int k = 0; k < 8; ++k) { const size_t i = i0 + (size_t)k * G * NT; v[k] = (i < n4) ? ((const f32x4*)x_in)[i] : (f32x4){0.f, 0.f, 0.f, 0.f}; }
#pragma unroll
            for (int k = 0; k < 8; ++k) { const size_t i = i0 + (size_t)k * G * NT; if (i < n4) { u32x2 w; w.x = pk2(v[k].x, v[k].y); w.y = pk2(v[k].z, v[k].w); ((u32x2*)XB)[i] = w; } }
        }
        const size_t m4 = (size_t)BATCH * NMEM * D / 4;
        for (size_t i = (size_t)bid * NT + tid; i < m4; i += (size_t)G * NT) {
            const f32x4 v = ((const f32x4*)mem)[i];
            u32x2 w; w.x = pk2(v.x, v.y); w.y = pk2(v.z, v.w);
            ((u32x2*)MEMB)[i] = w;
        }
        if (wave == 0) for (int i = bid * 64 + lane; i < DEPTH * 2 * SG * SP; i += G * 64) {
            const float lr = KIN(5)[i], li = KIN(6)[i], st = expf(KIN(7)[i >> 6]);
            const float mag = expf(lr * st), lbr = mag * cosf(li * st), lbi = mag * sinf(li * st);
            const float nr = lbr - 1.f, ni = lbi, den = lr * lr + li * li;
            float pr = 1.f, pi = 0.f; float* pt = PTAB + ((size_t)(i >> 6) * 17 * 64 + (i & 63)) * 2;
            float p16r = 0.f, p16i = 0.f;
#pragma unroll 1
            for (int k = 0; k <= TCH; ++k) { *(f32x2*)(pt + (size_t)k * 128) = (f32x2){pr, pi}; p16r = pr; p16i = pi; const float t = pr * lbr - pi * lbi; pi = pr * lbi + pi * lbr; pr = t; }
            *(f32x4*)(S5TAB + (size_t)i * 8) = (f32x4){lbr, lbi, (nr * lr + ni * li) / den, (ni * lr - nr * li) / den};
            *(f32x4*)(S5TAB + (size_t)i * 8 + 4) = (f32x4){p16r, p16i, 0.f, 0.f};
        }
        for (int it = gw; it < DEPTH * 512; it += NGW) { const int l = it / 512, q = it % 512;
            transpose_item(KIN(19) + (size_t)l * D * 1024, 1024, (q / 32) * 64, (q % 32) * 32, WKVT + (size_t)l * 1024 * 1024, 1024, (q % 32) * 32, cscr, lane); }
    }
    GRID_BAR();
    {
        struct KVOrder { const char* A; const char* B; int G, c;
            __device__ __forceinline__ bool next(int i, pg8::Unit& u) const { const int L = i * G + c; if (L >= 64) return false;
                u.x0 = L >> 4; u.pm = (L >> 3) & 1; u.pn = L & 7; u.x1 = 0; u.A = A + (size_t)u.pm * 256 * 2048; u.B = B + ((size_t)u.x0 * 1024 + (size_t)u.pn * 128) * 2048; return true; } };
        PHASE_PTRS();
        KVOrder S{(const char*)MEMB, (const char*)WKVT, G, bid_l};
        EpiKV E{KB, VT};
        pg8::gemm_phase<EpiKV, KVOrder, false, 1>(lds, wv, 1024, 1024, 1024, S, E);
    }
    {
        PHASE_IDS(); PHASE_PTRS();
        float* sP = smf;
        float* sC = smf + 2048;
        float* sX = smf + 4096;
        for (int item = bid_l; item < DEPTH * SG * 2; item += G) {
            const int d = item & 1, g = (item >> 1) & 31, l = item >> 6;
            __syncthreads();
            for (int i = tid; i < 1024; i += NT) {
                const int p = i >> 4, k = i & 15; const size_t ti = (size_t)((l * 2 + d) * SG + g) * SP + p;
                { const f32x2 pv = *(const f32x2*)(PTAB + (((size_t)((l * 2 + d) * SG + g) * 17 + k) * 64 + p) * 2); sP[i * 2] = pv.x; sP[i * 2 + 1] = pv.y; }
                const float fr = S5TAB[ti * 8 + 2], fi = S5TAB[ti * 8 + 3];
                const float br = KIN(8)[((size_t)(l * SG + g) * 64 + p) * 16 + k], bi = KIN(9)[((size_t)(l * SG + g) * 64 + p) * 16 + k];
                sX[i * 2] = fr * br - fi * bi; sX[i * 2 + 1] = fr * bi + fi * br;
                const int h = i >> 6, pp = i & 63;
                sC[i * 2] = KIN(10)[((size_t)(l * SG + g) * 16 + h) * 64 + pp]; sC[i * 2 + 1] = KIN(11)[((size_t)(l * SG + g) * 16 + h) * 64 + pp];
            }
            __syncthreads();
            {
                const int hh = tid & 1, h = (tid >> 1) & 15, tau = tid >> 5;
                float acc[8];
#pragma unroll
                for (int j = 0; j < 8; ++j) acc[j] = 0.f;
                for (int p = 0; p < 64; ++p) {
                    const float cr = sC[(h * 64 + p) * 2], ci = sC[(h * 64 + p) * 2 + 1], pr = sP[(p * 16 + tau) * 2], pi = sP[(p * 16 + tau) * 2 + 1];
                    const float wr = cr * pr - ci * pi, wi = cr * pi + ci * pr;
#pragma unroll
                    for (int j = 0; j < 8; ++j) acc[j] += wr * sX[(p * 16 + hh * 8 + j) * 2] - wi * sX[(p * 16 + hh * 8 + j) * 2 + 1];
                }
                float* o = KTAB + ((((size_t)(l * SG + g) * 2 + d) * TCH + tau) * 16 + h) * 16 + hh * 8;
                *(f32x4*)o = (f32x4){acc[0], acc[1], acc[2], acc[3]}; *(f32x4*)(o + 4) = (f32x4){acc[4], acc[5], acc[6], acc[7]};
            }
        }
        __syncthreads();
    }
    GRID_BAR();
    {
        PHASE_IDS(); PHASE_PTRS();
        const int NE = DEPTH * SG * 256 * 32, NB = DEPTH * SG * 256 * 64;
#pragma unroll 4
        for (int it = bid * NT + tid; it < NE; it += G * NT) {
            float v[8];
            {
                const int kg = it & 31, n = (it >> 5) & 255, g = (it >> 13) & 31, l = it >> 18;
                const int k0 = kg * 8, sp = k0 >> 4, h0 = k0 & 15, d = n >> 7, ri = (n >> 6) & 1, p = n & 63;
                const size_t ti = (size_t)((l * 2 + d) * SG + g) * SP + p;
                const int e = (d == 0) ? (TCH - 1 - sp) : sp;
                const f32x2 pv = *(const f32x2*)(PTAB + (((size_t)((l * 2 + d) * SG + g) * 17 + e) * 64 + p) * 2); const f32x2 fv = *(const f32x2*)(S5TAB + ti * 8 + 2);
                const float pr = pv.x, pi = pv.y, fr = fv.x, fi = fv.y;
                const float xr = pr * fr - pi * fi, xi = pr * fi + pi * fr;
                const f32x4* brp = (const f32x4*)(KIN(8) + ((size_t)(l * SG + g) * 64 + p) * 16 + h0); const f32x4* bip = (const f32x4*)(KIN(9) + ((size_t)(l * SG + g) * 64 + p) * 16 + h0);
                const f32x4 br0 = brp[0], br1 = brp[1], bi0 = bip[0], bi1 = bip[1];
                const float br[8] = {br0.x, br0.y, br0.z, br0.w, br1.x, br1.y, br1.z, br1.w}, bi[8] = {bi0.x, bi0.y, bi0.z, bi0.w, bi1.x, bi1.y, bi1.z, bi1.w};
#pragma unroll
                for (int j = 0; j < 8; ++j) v[j] = ri ? (xr * bi[j] + xi * br[j]) : (xr * br[j] - xi * bi[j]);
                u32x4 w; w.x = pk2(v[0], v[1]); w.y = pk2(v[2], v[3]); w.z = pk2(v[4], v[5]); w.w = pk2(v[6], v[7]);
                *(u32x4*)(S5E + ((size_t)(l * SG + g) * 256 + n) * 256 + k0) = w;
            }
        }
#pragma unroll 4
        for (int it = NE + bid * NT + tid; it < NE + NB; it += G * NT) {
            float v[8];
            {
                const int r = it - NE, kg = r & 63, n = (r >> 6) & 255, g = (r >> 14) & 31, l = r >> 19;
                const int k0 = kg * 8, s = n >> 4, h = n & 15;
                if (k0 < 256) {
                    const int sp = k0 >> 4, h0 = k0 & 15;
                    const float* kt = KTAB + (size_t)(l * SG + g) * 2 * TCH * 256;
#pragma unroll
                    for (int j = 0; j < 8; ++j) v[j] = 0.f;
                    if (sp <= s) { const f32x4* q = (const f32x4*)(kt + (0 * TCH + (s - sp)) * 256 + h * 16 + h0); const f32x4 a = q[0], b = q[1];
                        v[0] += a.x; v[1] += a.y; v[2] += a.z; v[3] += a.w; v[4] += b.x; v[5] += b.y; v[6] += b.z; v[7] += b.w; }
                    if (sp >= s) { const f32x4* q = (const f32x4*)(kt + (1 * TCH + (sp - s)) * 256 + h * 16 + h0); const f32x4 a = q[0], b = q[1];
                        v[0] += a.x; v[1] += a.y; v[2] += a.z; v[3] += a.w; v[4] += b.x; v[5] += b.y; v[6] += b.z; v[7] += b.w; }
                    if (sp == s) { const float dk = KIN(12)[(size_t)l * SSMW + g * 16 + h];
#pragma unroll
                        for (int j = 0; j < 8; ++j) if (h0 + j == h) v[j] += dk; }
                } else {
                    const int jj = k0 - 256, d = jj >> 7, ri = (jj >> 6) & 1, p0 = jj & 63;
                    const int e = (d == 0) ? (s + 1) : (TCH - s);
                    const float* cre = KIN(10) + ((size_t)(l * SG + g) * 16 + h) * 64 + p0; const float* cim = KIN(11) + ((size_t)(l * SG + g) * 16 + h) * 64 + p0;
                    const f32x4* pp = (const f32x4*)(PTAB + (((size_t)((l * 2 + d) * SG + g) * 17 + e) * 64 + p0) * 2);
                    const f32x4 p01 = pp[0], p23 = pp[1], p45 = pp[2], p67 = pp[3];
                    const float prv[8] = {p01.x, p01.z, p23.x, p23.z, p45.x, p45.z, p67.x, p67.z}, piv[8] = {p01.y, p01.w, p23.y, p23.w, p45.y, p45.w, p67.y, p67.w};
                    const f32x4 c0 = ((const f32x4*)cre)[0], c1 = ((const f32x4*)cre)[1], d0 = ((const f32x4*)cim)[0], d1 = ((const f32x4*)cim)[1];
                    const float crv[8] = {c0.x, c0.y, c0.z, c0.w, c1.x, c1.y, c1.z, c1.w}, civ[8] = {d0.x, d0.y, d0.z, d0.w, d1.x, d1.y, d1.z, d1.w};
#pragma unroll
                    for (int j = 0; j < 8; ++j) v[j] = ri ? -(crv[j] * piv[j] + civ[j] * prv[j]) : (crv[j] * prv[j] - civ[j] * piv[j]);
                }
                u32x4 w; w.x = pk2(v[0], v[1]); w.y = pk2(v[2], v[3]); w.z = pk2(v[4], v[5]); w.w = pk2(v[6], v[7]);
                *(u32x4*)(S5BT + ((size_t)(l * SG + g) * 256 + n) * 512 + k0) = w;
            }
        }
        __syncthreads();
        convert_early_share(ka, 0, (bf16*)(ws + WS_WBE0), bid * 8 + wave, G * 8, (LAS float*)(lds + wave * 16384), lane);
    }
    GRID_BAR();

#pragma unroll 1
    for (int l_iter = 0; l_iter < DEPTH; ++l_iter) {
        {
            PHASE_PTRS(); PHASE_LPTRS();
            pg8::DenseOrder S; S.init(XB, WBE + WE_CAT, M, 5120, D, D, G, bid_l);
            EpiP1 E{UG, GU, GV, QB, GATES, b_gate};
            pg8::gemm_phase<EpiP1, pg8::DenseOrder>(lds, wv, D, D, D, S, E);
        }
        GRID_BAR();

        {
            PHASE_PTRS(); PHASE_LPTRS();
            S5Order S{(const char*)UG, (const char*)(S5E + (size_t)l * SG * 256 * 256), (size_t)256 * 256 * 2, G, bid_l};
            EpiS5St E{SST};
            pg8::gemm_phase<EpiS5St, S5Order>(lds, wv, 512, 256, 256, S, E);
            int bidl = bid; asm volatile("" : "+s"(bidl));
            if (bidl < G / 2) {
                PHASE_IDS(); LAS float* cscr = (LAS float*)(lds + wave * 16384);
                for (int it = bid * 8 + wave; it < 6000; it += (G / 2) * 8) convert_late_item(ka, l, WBL, it, cscr, lane);
            }
            gmlp_phase(lds, wv, GU, GV, WBE + WE_SP, b_sp, gln_g, gln_b, YGMLP, G, bid_l);
        }
        GRID_BAR();
        {
            PHASE_IDS(); PHASE_PTRS(); PHASE_LPTRS();
            for (int item = bid; item < BATCH * SG * 2; item += G) {
                const int d = item & 1, g = (item >> 1) & 31, b = item >> 6, p = lane;
                const f32x4 tb = *(const f32x4*)(S5TAB + ((size_t)((l * 2 + d) * SG + g) * SP + p) * 8 + 4);
                const float ar = tb.x, ai = tb.y;
                const float* sp = SST + ((size_t)g * NCHK + (size_t)b * 512) * 256 + d * 128 + p;
                bf16* ap = UG + ((size_t)g * NCHK + (size_t)b * 512) * 512 + 256 + d * 128 + p;
                const int q0 = wave * 64;
                float hre[64], him[64];
                float hr = 0.f, hi = 0.f;
#pragma unroll
                for (int half = 0; half < 2; ++half) {
                    float sr[32], si[32];
#pragma unroll
                    for (int j = 0; j < 32; ++j) { const int q = q0 + half * 32 + j, c = d ? (511 - q) : q; sr[j] = sp[(size_t)c * 256]; si[j] = sp[(size_t)c * 256 + 64]; }
#pragma unroll
                    for (int j = 0; j < 32; ++j) { hre[half * 32 + j] = hr; him[half * 32 + j] = hi;
                        const float nr = ar * hr - ai * hi + sr[j], ni = ar * hi + ai * hr + si[j]; hr = nr; hi = ni; }
                }
                float* ex = smf + wave * 128;
                __syncthreads();
                ex[lane] = hr; ex[64 + lane] = hi;
                float a64r = ar, a64i = ai;
#pragma unroll
                for (int k = 0; k < 6; ++k) { const float t = a64r * a64r - a64i * a64i; a64i = 2.f * a64r * a64i; a64r = t; }
                __syncthreads();
                float cr = 0.f, ci = 0.f;
                for (int w2 = 0; w2 < wave; ++w2) { const float er = smf[w2 * 128 + lane], ei = smf[w2 * 128 + 64 + lane];
                    const float nr = a64r * cr - a64i * ci + er, ni = a64r * ci + a64i * cr + ei; cr = nr; ci = ni; }
                float pr = 1.f, pi = 0.f;
#pragma unroll
                for (int j = 0; j < 64; ++j) { const int q = q0 + j, c = d ? (511 - q) : q;
                    ap[(size_t)c * 512] = (bf16)f2bf(hre[j] + pr * cr - pi * ci); ap[(size_t)c * 512 + 64] = (bf16)f2bf(him[j] + pr * ci + pi * cr);
                    const float t = pr * ar - pi * ai; pi = pr * ai + pi * ar; pr = t; }
            }
            __syncthreads();
        }
        {
            PHASE_PTRS(); PHASE_LPTRS();
            attn_phase(lds, wv, QB, KB + (size_t)l * 2 * 4 * 256 * 128, VT + (size_t)l * 2 * 4 * 128 * 256, YMEM, G, bid_l);
            int bidl = bid; asm volatile("" : "+s"(bidl));
            if (bidl >= G / 2) {
                PHASE_IDS(); LAS float* cscr = (LAS float*)(lds + wave * 16384);
                for (int it = 6000 + (bid - G / 2) * 8 + wave; it < 6800; it += (G - G / 2) * 8) convert_late_item(ka, l, WBL, it, cscr, lane);
            }
        }
        GRID_BAR();
        {
            PHASE_PTRS(); PHASE_LPTRS();
            S5Order S{(const char*)UG, (const char*)(S5BT + (size_t)l * SG * 256 * 512), (size_t)256 * 512 * 2, G, bid_l};
            EpiS5Out E{YS};
            pg8::gemm_phase<EpiS5Out, S5Order>(lds, wv, 512, 512, 512, S, E);
            int bidl = bid; asm volatile("" : "+s"(bidl));
            {
                PHASE_IDS(); LAS float* cscr = (LAS float*)(lds + wave * 16384);
                if (bidl >= G / 2) { for (int it = 6800 + (bid - G / 2) * 8 + wave; it < CV_LATE; it += (G - G / 2) * 8) convert_late_item(ka, l, WBL, it, cscr, lane); }

            }
        }
        GRID_BAR();

        {
            PHASE_PTRS(); PHASE_LPTRS();
            GluOrder S{(const char*)YS, (const char*)(WBE + WE_GLU), G, bid_l};
            EpiGLU E{YS, YSSM, b_glu};
            pg8::gemm_phase<EpiGLU, GluOrder, false, 1>(lds, wv, 512, 512, 512, S, E);
        }
        GRID_BAR();
        {
            PHASE_PTRS(); PHASE_LPTRS();
            MergeOrder S{(const char*)YSSM, (const char*)YGMLP, (const char*)YMEM, (const char*)(WBE + WE_BR), G, bid_l};
            EpiMergeF E; E.GATES = GATES; E.MERGED = MERGED;
#pragma unroll
            for (int a_ = 0; a_ < 2; ++a_)
#pragma unroll
                for (int m_ = 0; m_ < 4; ++m_) { E.tot[a_][m_][0] = (f32x4){0.f, 0.f, 0.f, 0.f}; E.tot[a_][m_][1] = (f32x4){0.f, 0.f, 0.f, 0.f}; E.gv[a_][m_] = (u32x4){0u, 0u, 0u, 0u}; }
            pg8::gemm_phase<EpiMergeF, MergeOrder, false, 1>(lds, wv, 512, 512, 512, S, E);
        }
        GRID_BAR();
        {
            PHASE_PTRS(); PHASE_LPTRS();
            pg8::DenseOrder S; S.init(MERGED, WBE + WE_OUT, M, D, D, D, G, bid_l);
            EpiOut E{XB, (bf16*)Z1};
            pg8::gemm_phase<EpiOut, pg8::DenseOrder>(lds, wv, D, D, D, S, E);
        }
        GRID_BAR();

        { PHASE_IDS(); PHASE_PTRS(); PHASE_LPTRS(); unsigned* ecnt = ctl + CW_CNT + l * 32 * 64;
        LAS unsigned* lcnt = (LAS unsigned*)(lds + LDS_MISC + 1024); LAS unsigned* lbase = lcnt + 32; LAS int* lrec = (LAS int*)(lcnt + 64);
        const int tpw = (M + G - 1) / G;
        const int vb = bid;
        __syncthreads();
        if (tid < 32) lcnt[tid] = 0u;
        for (int i0 = tid; i0 < 9216; i0 += NT) {
            int i = i0 + (bid >> 3) * 288; if (i >= 9216) i -= 9216;
            const int a = i >> 10, r = i & 1023, pr = (r & ~63) | ((r & 3) << 4) | ((r >> 2) & 15);
            const f32x4 w = (a == 0) ? *(const f32x4*)(w_rg + (size_t)r * 4) : *(const f32x4*)(w_re + ((size_t)((a - 1) >> 1) * D + r) * 8 + ((a - 1) & 1) * 4);
            *(LAS f32x4*)(lds + ((size_t)a * 1024 + pr) * 16) = w;
        }
        __syncthreads();
        const int lrow = (lane >> 4) * 64 + (lane & 15);
        for (int ti0 = wave; ti0 < tpw; ti0 += 16) {
            f32x4 v[2][4]; float s[2], q[2], lg[2][4], le[2][8], pgv[2]; int gs[2], tiv[2], tokv[2]; bool ok[2];
#pragma unroll
            for (int t = 0; t < 2; ++t) {
                tiv[t] = ti0 + 8 * t; tokv[t] = vb * tpw + tiv[t]; ok[t] = (tiv[t] < tpw) && (tokv[t] < M);
                const bf16* zr = (const bf16*)Z1 + (size_t)(ok[t] ? tokv[t] : vb * tpw) * D; s[t] = 0.f;
#pragma unroll
                for (int j = 0; j < 4; ++j) { const u32x2 zw = *(const u32x2*)(zr + j * 256 + lane * 4); v[t][j] = (f32x4){bflo(zw.x), bfhi(zw.x), bflo(zw.y), bfhi(zw.y)}; s[t] += (v[t][j].x + v[t][j].y) + (v[t][j].z + v[t][j].w); }
            }
#pragma unroll
            for (int t = 0; t < 2; ++t) s[t] = wave_sum(s[t], lane) * (1.f / D);
#pragma unroll
            for (int t = 0; t < 2; ++t) { q[t] = 0.f;
#pragma unroll
                for (int j = 0; j < 4; ++j) { v[t][j] = v[t][j] - s[t]; q[t] += (v[t][j].x * v[t][j].x + v[t][j].y * v[t][j].y) + (v[t][j].z * v[t][j].z + v[t][j].w * v[t][j].w); } }
#pragma unroll
            for (int t = 0; t < 2; ++t) q[t] = rsqrtf(wave_sum(q[t], lane) * (1.f / D) + LN_EPS);
#pragma unroll
            for (int t = 0; t < 2; ++t)
#pragma unroll
                for (int g = 0; g < 4; ++g) lg[t][g] = 0.f;
#pragma unroll
            for (int j = 0; j < 4; ++j) {
                const int c0 = j * 256 + lane * 4;
                const f32x4 gg = *(const f32x4*)(ln1_g + c0), bb = *(const f32x4*)(ln1_b + c0);
#pragma unroll
                for (int t = 0; t < 2; ++t) {
                    v[t][j] = v[t][j] * q[t] * gg + bb;
                    if (ok[t]) { u32x2 w; w.x = pk2(v[t][j].x, v[t][j].y); w.y = pk2(v[t][j].z, v[t][j].w); *(u32x2*)(X1B + (size_t)tokv[t] * D + c0) = w; }
                }
#pragma unroll
                for (int e = 0; e < 4; ++e) {
                    const f32x4 wr = *(const LAS f32x4*)(lds + (j * 256 + lrow + 16 * e) * 16);
#pragma unroll
                    for (int t = 0; t < 2; ++t) { const float xv = v[t][j][e]; lg[t][0] += xv * wr.x; lg[t][1] += xv * wr.y; lg[t][2] += xv * wr.z; lg[t][3] += xv * wr.w; }
                }
            }
#pragma unroll
            for (int t = 0; t < 2; ++t) { wave_sum4(lg[t], lane);
#pragma unroll
                for (int g = 0; g < 4; ++g) lg[t][g] += b_rg[g]; }
#pragma unroll
            for (int t = 0; t < 2; ++t) {
                int gsel = 0; float gm = lg[t][0];
#pragma unroll
                for (int g = 1; g < 4; ++g) if (lg[t][g] > gm) { gm = lg[t][g]; gsel = g; }
                float den = 0.f;
#pragma unroll
                for (int g = 0; g < 4; ++g) den += __expf(lg[t][g] - gm);
                pgv[t] = 1.f / den; gs[t] = gsel;
#pragma unroll
                for (int e = 0; e < 8; ++e) le[t][e] = 0.f;
                const LAS unsigned char* wre = lds + 16384 + gsel * 32768;
#pragma unroll
                for (int j = 0; j < 4; ++j) {
#pragma unroll
                    for (int e = 0; e < 4; ++e) {
                        const f32x4 w0 = *(const LAS f32x4*)(wre + (j * 256 + lrow + 16 * e) * 16), w1 = *(const LAS f32x4*)(wre + 16384 + (j * 256 + lrow + 16 * e) * 16);
                        const float xv = v[t][j][e];
                        le[t][0] += xv * w0.x; le[t][1] += xv * w0.y; le[t][2] += xv * w0.z; le[t][3] += xv * w0.w;
                        le[t][4] += xv * w1.x; le[t][5] += xv * w1.y; le[t][6] += xv * w1.z; le[t][7] += xv * w1.w;
                    }
                }
            }
#pragma unroll
            for (int t = 0; t < 2; ++t) { wave_sum8(le[t], lane);
#pragma unroll
                for (int e = 0; e < 8; ++e) le[t][e] += b_re[gs[t] * 8 + e]; }
#pragma unroll
            for (int t = 0; t < 2; ++t) {
                int i0 = 0; float v0 = le[t][0];
#pragma unroll
                for (int e = 1; e < 8; ++e) if (le[t][e] > v0) { v0 = le[t][e]; i0 = e; }
                int i1 = -1; float v1 = -3.0e38f;
#pragma unroll
                for (int e = 0; e < 8; ++e) if (e != i0 && le[t][e] > v1) { v1 = le[t][e]; i1 = e; }
                const float p0 = 1.f / (1.f + __expf(v1 - v0)), p1 = 1.f - p0;
                if (lane == 0 && ok[t]) {
                    const int e0 = gs[t] * 8 + i0, e1 = gs[t] * 8 + i1;
                    const unsigned q0 = __hip_atomic_fetch_add(lcnt + e0, 1u, __ATOMIC_RELAXED, __HIP_MEMORY_SCOPE_WORKGROUP), q1 = __hip_atomic_fetch_add(lcnt + e1, 1u, __ATOMIC_RELAXED, __HIP_MEMORY_SCOPE_WORKGROUP);
                    lrec[tiv[t] * 4 + 0] = e0; lrec[tiv[t] * 4 + 1] = e1; lrec[tiv[t] * 4 + 2] = (int)q0; lrec[tiv[t] * 4 + 3] = (int)q1;
                    TOKW[tokv[t] * 2] = pgv[t] * p0; TOKW[tokv[t] * 2 + 1] = pgv[t] * p1;
                }
            }
        }
        __syncthreads();
        if (tid < 32) { const unsigned n = lcnt[tid]; lbase[tid] = n ? atomicAdd(&ecnt[tid * 64], n) : 0u; }
        __syncthreads();
        for (int ti = tid; ti < tpw; ti += NT) { const int tok = vb * tpw + ti;
            if (tok < M) { const int e0 = lrec[ti * 4], e1 = lrec[ti * 4 + 1];
                LIST[(size_t)e0 * LCAP + lbase[e0] + lrec[ti * 4 + 2]] = tok * 2; LIST[(size_t)e1 * LCAP + lbase[e1] + lrec[ti * 4 + 3]] = tok * 2 + 1; } }
        __syncthreads();
        }
        GRID_BAR();

        if (opaque_tid(wv) == 0) {
            PHASE_PTRS(); PHASE_LPTRS(); unsigned* ecnt = ctl + CW_CNT + l * 32 * 64;
            int tb = 0, sb = 0;
            for (int e = 0; e < NEXP; ++e) { const int cnt = (int)xb_ld(&ecnt[e * 64]); const int nrt = (cnt + 255) >> 8; mtab->tb[e] = tb; mtab->sb[e] = sb; mtab->cn[e] = cnt; tb += nrt; sb += nrt * 256; }
            mtab->tb[32] = tb; mtab->sb[32] = sb;
        }
        __syncthreads();
        {
            PHASE_PTRS(); PHASE_LPTRS();
            const int NX = (G % 8 == 0) ? 8 : 1, Gx = G / NX, x = bid_l % NX, kx = bid_l / NX;
            const int Tx = moe_ntile_x(mtab, x, NX), NGU = 2 * Tx;
            unsigned* tcnt = ctl + CW_TC + (size_t)l * 160 * 64;
#define MOE_GU_UNIT(lu_) do { const int lu = (lu_); int e, pm; moe_local_tile(mtab, x, NX, lu >> 1, e, pm); \
                const int cnt = __builtin_amdgcn_readfirstlane(mtab->cn[e]), t = __builtin_amdgcn_readfirstlane(mtab->tb[e]) + pm; \
                MoeOrderGU S{(const char*)X1B, (const char*)(WBL + WL_GU), LIST, e, pm, cnt, lu & 1}; \
                EpiMoeGU E; E.T = mtab; E.LIST = LIST; E.TOKW = TOKW; E.HB = HB; E.init(e, pm, cnt, opaque_tid(wv)); \
                pg8::gemm_phase<EpiMoeGU, MoeOrderGU, true>(lds, wv, D, D, D, S, E); \
                  \
                if (opaque_tid(wv) == 0) { __builtin_amdgcn_fence(__ATOMIC_RELEASE, "agent"); asm volatile("s_waitcnt vmcnt(0)" ::: "memory"); (void)xb_add(&tcnt[t * 64], 1u); } } while (0)
            if (kx < NGU) MOE_GU_UNIT(kx);
#pragma unroll 1
            for (int lu2 = kx + Gx; lu2 < NGU; lu2 += Gx) MOE_GU_UNIT(lu2);
#undef MOE_GU_UNIT
            {
                const int R2 = (NGU > Gx) ? (NGU - Gx) : 0;
                int j, We;
                if (R2 < Gx) { We = Gx - R2; j = kx - R2; } else { We = Gx; j = kx; }
                const int Te = (R2 < Gx) ? ((Tx < Gx / 2) ? Tx : (Gx / 2)) : 0, NDe = 4 * Te, ND = 4 * Tx;
#define MOE_D_CALL(d0_, d1_) do { const int dd0 = (d0_), dd1 = (d1_); \
                if (j >= 0 && dd0 < dd1) { \
                    if (opaque_tid(wv) == 0) { unsigned* bw = ctl + CW_BAR; \
                        for (int du = dd0; du < dd1; du += We) { int e, pm; moe_local_tile(mtab, x, NX, du >> 2, e, pm); const int t = mtab->tb[e] + pm; XB_SPIN(xb_ld(&tcnt[t * 64]) < 2u, bw); } \
                        __builtin_amdgcn_fence(__ATOMIC_ACQUIRE, "agent"); asm volatile("s_waitcnt vmcnt(0)" ::: "memory"); } \
                    __syncthreads(); \
                    MoeOrderD S{mtab, (const char*)HB, (const char*)(WBL + WL_D), x, NX, dd0, We, dd1}; \
                    EpiMoeD E; E.LIST = LIST; E.O2 = O2; _Pragma("unroll") for (int a_ = 0; a_ < 2; ++a_) _Pragma("unroll") for (int m_ = 0; m_ < 4; ++m_) E.pr[a_][m_] = 0; \
                    pg8::gemm_phase<EpiMoeD, MoeOrderD>(lds, wv, DEXP, DEXP, DEXP, S, E); } } while (0)
                MOE_D_CALL(j, NDe);
                MOE_D_CALL(NDe + j, ND);
#undef MOE_D_CALL
            }
            if (l + 1 < DEPTH) {
                PHASE_IDS();
                convert_early_share(ka, l + 1, (bf16*)(ws + (((l + 1) & 1) ? WS_WBE1 : WS_WBE0)), bid_l * 8 + wave, G * 8, (LAS float*)(lds + wave * 16384), lane);
            }
        }
        GRID_BAR();

        { PHASE_IDS(); PHASE_PTRS(); PHASE_LPTRS();
        float* outp = *(float* const __attribute__((address_space(4)))*)(ka + 264);
        for (int tok0 = bid * 8 + wave; tok0 < M; tok0 += G * 16) {
            f32x4 v[2][4]; float s[2], q[2]; int tk[2];
#pragma unroll
            for (int t = 0; t < 2; ++t) {
                tk[t] = tok0 + t * G * 8; const int tok = (tk[t] < M) ? tk[t] : tok0; s[t] = 0.f;
                const bf16* xr = X1B + (size_t)tok * D;
#pragma unroll
                for (int j = 0; j < 4; ++j) {
                    const int c0 = j * 256 + lane * 4;
                    const u32x2 xw = *(const u32x2*)(xr + c0);
                    const u32x2 a = *(const u32x2*)(O2 + (size_t)(tok * 2) * D + c0), b = *(const u32x2*)(O2 + (size_t)(tok * 2 + 1) * D + c0);
                    v[t][j].x = ALPHA * bflo(xw.x) + bflo(a.x) + bflo(b.x); v[t][j].y = ALPHA * bfhi(xw.x) + bfhi(a.x) + bfhi(b.x);
                    v[t][j].z = ALPHA * bflo(xw.y) + bflo(a.y) + bflo(b.y); v[t][j].w = ALPHA * bfhi(xw.y) + bfhi(a.y) + bfhi(b.y);
                    s[t] += (v[t][j].x + v[t][j].y) + (v[t][j].z + v[t][j].w);
                }
            }
#pragma unroll
            for (int t = 0; t < 2; ++t) s[t] = wave_sum(s[t], lane) * (1.f / D);
#pragma unroll
            for (int t = 0; t < 2; ++t) { q[t] = 0.f;
#pragma unroll
                for (int j = 0; j < 4; ++j) { v[t][j] = v[t][j] - s[t]; q[t] += (v[t][j].x * v[t][j].x + v[t][j].y * v[t][j].y) + (v[t][j].z * v[t][j].z + v[t][j].w * v[t][j].w); } }
#pragma unroll
            for (int t = 0; t < 2; ++t) q[t] = rsqrtf(wave_sum(q[t], lane) * (1.f / D) + LN_EPS);
#pragma unroll
            for (int t = 0; t < 2; ++t) {
                if (tk[t] < M) {
#pragma unroll
                    for (int j = 0; j < 4; ++j) {
                        const int c0 = j * 256 + lane * 4;
                        const f32x4 gg = *(const f32x4*)(ln2_g + c0), bb = *(const f32x4*)(ln2_b + c0);
                        const f32x4 o = v[t][j] * q[t] * gg + bb;
                        if (l == DEPTH - 1) *(f32x4*)(outp + (size_t)tk[t] * D + c0) = o;
                        else { u32x2 w; w.x = pk2(o.x, o.y); w.y = pk2(o.z, o.w); *(u32x2*)(XB + (size_t)tk[t] * D + c0) = w; }
                    }
                }
            }
        } }
        if (l_iter != DEPTH - 1) GRID_BAR();
    }
}

extern "C" void kernel_launch(void* const* d_in, const int* in_sizes, int n_in, void* d_out, int out_size, void* d_ws, size_t ws_size, hipStream_t stream) {
    static int grid = 0;
    if (grid == 0) {
        if (n_in != 33 || out_size != M * D || ws_size < WS_END) { fprintf(stderr, "kernel_launch: unexpected shapes n_in %d out %d ws %zu (need %zu)\n", n_in, out_size, ws_size, (size_t)WS_END); grid = -1; return; }
        int dev = 0, cus = 0, per_cu = 0;
        if (hipGetDevice(&dev) != hipSuccess || hipDeviceGetAttribute(&cus, hipDeviceAttributeMultiprocessorCount, dev) != hipSuccess) { grid = -1; return; }
        if (hipFuncSetAttribute((const void*)fwd_kernel, hipFuncAttributeMaxDynamicSharedMemorySize, LDS_BYTES) != hipSuccess) { fprintf(stderr, "kernel_launch: hipFuncSetAttribute failed\n"); grid = -1; return; }
        if (hipOccupancyMaxActiveBlocksPerMultiprocessor(&per_cu, (const void*)fwd_kernel, NT, LDS_BYTES) != hipSuccess || per_cu < 1) { fprintf(stderr, "kernel_launch: occupancy query says %d\n", per_cu); per_cu = 1; }
        (void)hipGetLastError();
        grid = cus;
        if (grid < 160) { fprintf(stderr, "kernel_launch: built for a grid of >= 160 workgroups (MoE phase: one row tile per workgroup); device has %d CUs\n", cus); grid = -1; return; }
    }
    if (grid < 0) return;
    (void)hipMemsetAsync((char*)d_ws + WS_CTL, 0, CTL_ZERO_BYTES, stream);
    Args a{};
    for (int i = 0; i < 33; ++i) a.in[i] = (const float*)d_in[i];
    a.out = (float*)d_out; a.ws = (unsigned char*)d_ws;
    hipLaunchKernelGGL(fwd_kernel, dim3(grid), dim3(NT), LDS_BYTES, stream, a);
}
```
